# Optimizing an MI355X kernel written in HIP

```python
import jax, jax.numpy as jnp
from jax import lax
import numpy as np

D_MODEL = 1024
BATCH = 8
SEQ = 4096
DEPTH = 1
DEC_BATCH = 128
DEC_SEQ = 8
PAST_LEN = 16384
PAGE_SIZE = 128

MIX_WIDTH = D_MODEL
HG_WIDTH = MIX_WIDTH // 2
HG_EXPAND = 128
HG_HEADS = HG_WIDTH // HG_EXPAND
HG_DK = HG_EXPAND
HG_DV = HG_WIDTH // HG_HEADS
HG_CHUNK = 32
SWA_WIDTH = MIX_WIDTH - HG_WIDTH
SWA_HEAD_DIM = 64
SWA_Q_HEADS = SWA_WIDTH // SWA_HEAD_DIM
SWA_KV_HEADS = 2
SWA_GROUP = SWA_Q_HEADS // SWA_KV_HEADS
WINDOW = 128
SWA_SCALE = SWA_HEAD_DIM ** -0.5
D_FF = 4 * D_MODEL
EPS = 1e-6
IN_SPLITS = (HG_WIDTH, HG_WIDTH, HG_WIDTH, HG_WIDTH,
             SWA_Q_HEADS * SWA_HEAD_DIM, SWA_KV_HEADS * SWA_HEAD_DIM, SWA_KV_HEADS * SWA_HEAD_DIM)
N_IN = sum(IN_SPLITS)

kernel_name = 'hymba_hgrn2_swa_sink_decoder_step'


def _rmsnorm(x, g):
    xf = x.astype(jnp.float32)
    y = xf * lax.rsqrt(jnp.mean(xf * xf, axis=-1, keepdims=True) + EPS)
    return (y * g.astype(jnp.float32)).astype(x.dtype)


def _split(z):
    outs, off = [], 0
    for w in IN_SPLITS:
        outs.append(z[..., off:off + w])
        off += w
    return outs


def _gla_chunked(q, k, v, log_f, S0):
    B, T, H, DK = q.shape
    DV = v.shape[-1]
    L = min(HG_CHUNK, T)
    pad = (-T) % L
    if pad:
        pw = ((0, 0), (0, pad), (0, 0), (0, 0))
        q, k, v, log_f = [jnp.pad(a, pw) for a in (q, k, v, log_f)]
    NC = (T + pad) // L

    def blocks(a):
        return a.reshape(B, NC, L, H, a.shape[-1]).transpose(1, 0, 3, 2, 4)

    q, k, v, g = blocks(q), blocks(k), blocks(v), blocks(log_f)
    b = jnp.cumsum(g, axis=3)
    b_last = b[:, :, :, -1:, :]
    qt = q * jnp.exp(b)
    kt = k * jnp.exp(-b)
    ke = k * jnp.exp(b_last - b)
    decay = jnp.exp(b_last[:, :, :, 0, :])
    causal = jnp.tril(jnp.ones((L, L), dtype=bool))
    A = jnp.where(causal, jnp.einsum('nbhtd,nbhsd->nbhts', qt, kt), 0.0)
    o_intra = jnp.einsum('nbhts,nbhsv->nbhtv', A, v)

    def step(S, xs):
        qt_n, ke_n, v_n, dec_n = xs
        o_n = jnp.einsum('bhtd,bhdv->bhtv', qt_n, S)
        S = dec_n[..., None] * S + jnp.einsum('bhsd,bhsv->bhdv', ke_n, v_n)
        return S, o_n

    S_fin, o_inter = lax.scan(step, S0, (qt, ke, v, decay))
    o = (o_intra + o_inter).transpose(1, 0, 3, 2, 4).reshape(B, NC * L, H, DV)[:, :T]
    return o, S_fin


def _hgrn2(zq, zf, zi, zg, lb, g_norm, S0):
    B, T, _ = zq.shape
    f32 = jnp.float32
    q = jax.nn.silu(zq.astype(f32)).reshape(B, T, HG_HEADS, HG_DK)
    fl = zf.astype(f32).reshape(B, T, HG_HEADS, HG_DK)
    lb = lb.astype(f32)
    f = lb + (1.0 - lb) * jax.nn.sigmoid(fl)
    k = (1.0 - lb) * jax.nn.sigmoid(-fl)
    v = zi.astype(f32).reshape(B, T, HG_HEADS, HG_DV)
    o, S = _gla_chunked(q, k, v, jnp.log(f), S0.astype(f32))
    o = _rmsnorm(o, g_norm)
    o = o.reshape(B, T, HG_WIDTH) * jax.nn.silu(zg.astype(f32))
    return o.astype(zq.dtype), S.astype(S0.dtype)


def _sink_softmax(s, mask, sink):
    s = jnp.where(mask, s, -jnp.inf)
    m = jnp.maximum(jnp.max(s, axis=-1, keepdims=True), sink)
    p = jnp.exp(s - m)
    return p / (jnp.sum(p, axis=-1, keepdims=True) + jnp.exp(sink - m))


def _swa_prompt(q, k, v, sinks):
    B, T = q.shape[:2]
    W = WINDOW
    NB = T // W
    f32 = jnp.float32
    qb = q.astype(f32).reshape(B, NB, W, SWA_KV_HEADS, SWA_GROUP, SWA_HEAD_DIM)
    kb = k.astype(f32).reshape(B, NB, W, SWA_KV_HEADS, SWA_HEAD_DIM)
    vb = v.astype(f32).reshape(B, NB, W, SWA_KV_HEADS, SWA_HEAD_DIM)
    prev = lambda a: jnp.pad(a[:, :-1], ((0, 0), (1, 0), (0, 0), (0, 0), (0, 0)))
    kk = jnp.concatenate([prev(kb), kb], axis=2)
    vv = jnp.concatenate([prev(vb), vb], axis=2)
    s = jnp.einsum('bnqkgd,bnskd->bnkgqs', qb, kk) * SWA_SCALE
    n = jnp.arange(NB)[:, None, None]
    i = jnp.arange(W)[None, :, None]
    j = jnp.arange(2 * W)[None, None, :]
    kpos = (n - 1) * W + j
    d = n * W + i - kpos
    mask = ((d >= 0) & (d < WINDOW) & (kpos >= 0))[None, :, None, None]
    sink = sinks.astype(f32).reshape(SWA_KV_HEADS, SWA_GROUP)[None, None, :, :, None, None]
    p = _sink_softmax(s, mask, sink)
    o = jnp.einsum('bnkgqs,bnskd->bnqkgd', p, vv)
    return o.reshape(B, T, SWA_WIDTH).astype(q.dtype)


def _swa_sample(q, k_new, v_new, ck, cv, sinks):
    DB, S = q.shape[:2]
    WB = ck.shape[1]
    f32 = jnp.float32
    kk = jnp.concatenate([ck, k_new.astype(ck.dtype)], axis=1)
    vv = jnp.concatenate([cv, v_new.astype(cv.dtype)], axis=1)
    qpos = PAST_LEN + jnp.arange(S)
    kpos = jnp.concatenate([PAST_LEN - WB + jnp.arange(WB), PAST_LEN + jnp.arange(S)])
    d = qpos[:, None] - kpos[None, :]
    mask = ((d >= 0) & (d < WINDOW))[None, None, None]
    qg = q.astype(f32).reshape(DB, S, SWA_KV_HEADS, SWA_GROUP, SWA_HEAD_DIM)
    s = jnp.einsum('bqkgd,bskd->bkgqs', qg, kk.astype(f32)) * SWA_SCALE
    sink = sinks.astype(f32).reshape(SWA_KV_HEADS, SWA_GROUP)[None, :, :, None, None]
    p = _sink_softmax(s, mask, sink)
    o = jnp.einsum('bkgqs,bskd->bqkgd', p, vv.astype(f32))
    return o.reshape(DB, S, SWA_WIDTH).astype(q.dtype), kk[:, -WB:], vv[:, -WB:]


def _layer(h, ln_mix, w_in, lb, hg_norm, sinks, w_out, ln_mlp, w_up, w_down, S0, ck=None, cv=None):
    B, T, _ = h.shape
    xn = _rmsnorm(h, ln_mix)
    zq, zf, zi, zg, sq, sk, sv = _split(xn @ w_in)
    o_hg, S_new = _hgrn2(zq, zf, zi, zg, lb, hg_norm, S0)
    q = sq.reshape(B, T, SWA_Q_HEADS, SWA_HEAD_DIM)
    k = sk.reshape(B, T, SWA_KV_HEADS, SWA_HEAD_DIM)
    v = sv.reshape(B, T, SWA_KV_HEADS, SWA_HEAD_DIM)
    if ck is None:
        o_swa = _swa_prompt(q, k, v, sinks)
        wb = min(WINDOW, T)
        k_buf, v_buf = k[:, -wb:], v[:, -wb:]
    else:
        o_swa, k_buf, v_buf = _swa_sample(q, k, v, ck, cv, sinks)
    h = h + jnp.concatenate([o_hg, o_swa], axis=-1) @ w_out
    u = _rmsnorm(h, ln_mlp) @ w_up
    h = h + jnp.square(jax.nn.relu(u)) @ w_down
    return h, S_new, k_buf, v_buf


def setup_inputs(seed: int = 0) -> dict:
    key = jax.random.key(seed)
    ks = jax.random.split(key, 16)
    WB = min(WINDOW, PAST_LEN)
    nrm = jax.random.normal
    f32 = jnp.float32
    return {
        'x_prompt': nrm(ks[0], (BATCH, SEQ, D_MODEL), f32),
        'x_sample': nrm(ks[1], (DEC_BATCH, DEC_SEQ, D_MODEL), f32),
        'state_hgrn': 0.5 * nrm(ks[2], (DEPTH, DEC_BATCH, HG_HEADS, HG_DK, HG_DV), f32),
        'cache_swa_k': nrm(ks[3], (DEPTH, DEC_BATCH, WB, SWA_KV_HEADS, SWA_HEAD_DIM), f32),
        'cache_swa_v': nrm(ks[4], (DEPTH, DEC_BATCH, WB, SWA_KV_HEADS, SWA_HEAD_DIM), f32),
        'ln_mix': 1.0 + 0.02 * nrm(ks[5], (DEPTH, D_MODEL), f32),
        'w_in': nrm(ks[6], (DEPTH, D_MODEL, N_IN), f32) * D_MODEL ** -0.5,
        'lb_logits': 0.1 * nrm(ks[7], (DEPTH + 1, HG_HEADS * HG_DK), f32),
        'hg_norm': 1.0 + 0.02 * nrm(ks[8], (DEPTH, HG_DV), f32),
        'sinks': nrm(ks[9], (DEPTH, SWA_Q_HEADS), f32),
        'w_out': nrm(ks[10], (DEPTH, MIX_WIDTH, D_MODEL), f32) * MIX_WIDTH ** -0.5,
        'ln_mlp': 1.0 + 0.02 * nrm(ks[11], (DEPTH, D_MODEL), f32),
        'w_up': nrm(ks[12], (DEPTH, D_MODEL, D_FF), f32) * D_MODEL ** -0.5,
        'w_down': nrm(ks[13], (DEPTH, D_FF, D_MODEL), f32) * D_FF ** -0.5,
        'ln_final': 1.0 + 0.02 * nrm(ks[14], (D_MODEL,), f32),
    }


def reference(x_prompt, x_sample, state_hgrn, cache_swa_k, cache_swa_v, ln_mix, w_in, lb_logits,
              hg_norm, sinks, w_out, ln_mlp, w_up, w_down, ln_final):
    lbs = jnp.cumsum(jax.nn.softmax(lb_logits.astype(jnp.float32), axis=0), axis=0)
    hp, hs = x_prompt, x_sample
    sp_l, kp_l, vp_l, ss_l, ks_l, vs_l = [], [], [], [], [], []
    for l in range(DEPTH):
        lb = lbs[l].reshape(HG_HEADS, HG_DK)
        w = (ln_mix[l], w_in[l], lb, hg_norm[l], sinks[l], w_out[l], ln_mlp[l], w_up[l], w_down[l])
        S0p = jnp.zeros((hp.shape[0], HG_HEADS, HG_DK, HG_DV), state_hgrn.dtype)
        hp, sp, kp, vp = _layer(hp, *w, S0p)
        hs, ss, kss, vss = _layer(hs, *w, state_hgrn[l], cache_swa_k[l], cache_swa_v[l])
        sp_l.append(sp); kp_l.append(kp.astype(cache_swa_k.dtype)); vp_l.append(vp.astype(cache_swa_v.dtype))
        ss_l.append(ss); ks_l.append(kss); vs_l.append(vss)
    y_prompt = _rmsnorm(hp, ln_final)
    y_sample = _rmsnorm(hs, ln_final)
    return (y_prompt, y_sample, jnp.stack(sp_l), jnp.stack(kp_l), jnp.stack(vp_l),
            jnp.stack(ss_l), jnp.stack(ks_l), jnp.stack(vs_l))
```

```cpp
#include <hip/hip_runtime.h>
#include <hip/hip_cooperative_groups.h>
#include <cstdio>
#include <cstdint>
namespace cg = cooperative_groups;

#ifndef MK_COOP
#define MK_COOP 1
#endif

#define DI __device__ __forceinline__
#define LAS __attribute__((address_space(3)))
typedef unsigned short bf16_t;
typedef short bf16x8 __attribute__((ext_vector_type(8)));
typedef short s16x4 __attribute__((ext_vector_type(4)));
typedef float f32x4 __attribute__((ext_vector_type(4)));
typedef float f32x16 __attribute__((ext_vector_type(16)));
typedef unsigned u32x4 __attribute__((ext_vector_type(4)));
typedef unsigned u32x2 __attribute__((ext_vector_type(2)));
typedef float f32x2_t __attribute__((ext_vector_type(2)));
typedef __bf16 bf16x2_t __attribute__((ext_vector_type(2)));

DI unsigned pk2(float lo, float hi) { f32x2_t v = {lo, hi}; bf16x2_t b = __builtin_convertvector(v, bf16x2_t); return __builtin_bit_cast(unsigned, b); }
DI float bf2f(bf16_t v) { return __uint_as_float(((unsigned)v) << 16); }
DI float bflo(unsigned w) { return __uint_as_float(w << 16); }
DI float bfhi(unsigned w) { return __uint_as_float(w & 0xffff0000u); }
DI int crow(int reg, int h) { return (reg & 3) + 8 * (reg >> 2) + 4 * h; }
#define MFMA32(a, b, c) __builtin_amdgcn_mfma_f32_32x32x16_bf16((a), (b), (c), 0, 0, 0)
DI bf16x8 packs(const f32x16& x, int s) {
    u32x4 p; p.x = pk2(x[8 * s], x[8 * s + 1]); p.y = pk2(x[8 * s + 2], x[8 * s + 3]); p.z = pk2(x[8 * s + 4], x[8 * s + 5]); p.w = pk2(x[8 * s + 6], x[8 * s + 7]);
    return __builtin_bit_cast(bf16x8, p);
}
DI bf16x8 cat4(s16x4 lo, s16x4 hi) { return __builtin_shufflevector(lo, hi, 0, 1, 2, 3, 4, 5, 6, 7); }
DI float wave_sum(float v) {
#pragma unroll
    for (int o = 1; o < 64; o <<= 1) v += __shfl_xor(v, o);
    return v;
}

constexpr int DM = 1024, SEQ = 4096, NB = 8, NTP = NB * SEQ, DB = 128, DS = 8, NTS = DB * DS, M = NTP + NTS;
constexpr int NIN = 2816, FF = 4096;
constexpr int ZQ = 0, ZF = 512, ZI = 1024, ZG = 1536, ZSQ = 2048, ZSK = 2560, ZSV = 2688;
constexpr float EPS = 1e-6f;
constexpr size_t O_Y = 0, O_SP = (size_t)M * DM, O_KP = O_SP + 8 * 4 * 128 * 128, O_VP = O_KP + 8 * 128 * 128, O_SS = O_VP + 8 * 128 * 128,
                 O_KS = O_SS + (size_t)128 * 4 * 128 * 128, O_VS = O_KS + (size_t)128 * 128 * 128, O_END = O_VS + (size_t)128 * 128 * 128;
constexpr size_t MiB = 1u << 20;
constexpr size_t WS_RSS1 = 0, WS_RSS2 = 256 * 1024, WS_WIN = 1 * MiB, WS_WOUT = 7 * MiB, WS_WUP = 9 * MiB, WS_WDN = 17 * MiB, WS_DSC = 25 * MiB,
                 WS_XN = 26 * MiB, WS_Z = 92 * MiB, WS_MIX = 274 * MiB, WS_HS = 340 * MiB, WS_U = 92 * MiB, WS_END = 404 * MiB;
static_assert(WS_XN + (size_t)M * DM * 2 <= WS_Z && WS_Z + (size_t)M * NIN * 2 <= WS_MIX && WS_MIX + (size_t)M * DM * 2 <= WS_HS && WS_U + (size_t)M * FF * 2 <= WS_END, "ws map");
constexpr int LDS_BYTES = 147456;

namespace pg8 {
constexpr int BM = 256, BK = 64, HALF = 128, HTB = HALF * BK * 2, STAGE_BYTES = 8 * HTB, NXCD = 8, WGM = 8;
DI int lds_byte(int r, int c) { const int st = (r >> 4) * 2 + (c >> 5), rr = r & 15, cc = c & 31, ob = rr * 64 + cc * 2; return st * 1024 + (ob ^ (((ob >> 9) & 1) << 5)); }
DI void stage_rc(int b, int& R, int& C) { const int st = b / 1024, sb = b % 1024, swz = sb ^ (((sb >> 9) & 1) << 5); R = (st >> 1) * 16 + swz / 64; C = (st & 1) * 32 + (swz % 64) / 2; }
DI int perm32(int rho) { const int n = rho >> 4, i = rho & 15; return 8 * (i >> 2) + 4 * n + (i & 3); }
struct Unit { int pm, pn; };
struct Gemm { const bf16_t* A; const bf16_t* Bt; int M, N, K; };
struct StaticOrder {
    int nM, nN, nwg, G, c;
    DI void init(int M_, int N_, int G_, int c_) { nM = M_ / BM; nN = N_ / BM; nwg = nM * nN; G = G_; c = c_; }
    DI bool next(int i, Unit& u) const {
        const long L = (long)i * G + c; if (L >= nwg) return false;
        int wgid = (int)L; { const int q = nwg / NXCD, r = nwg % NXCD, xcd = wgid % NXCD, off = wgid / NXCD; wgid = (xcd < r ? xcd * (q + 1) : r * (q + 1) + (xcd - r) * q) + off; }
        const int nig = WGM * nN, gid = wgid / nig, fm = gid * WGM, gsz = (nM - fm) < WGM ? (nM - fm) : WGM;
        u.pm = fm + ((wgid % nig) % gsz); u.pn = (wgid % nig) / gsz; return true;
    }
};
struct EpiZ {
    static constexpr bool PERM = true;
    bf16_t* O; int ldc;
    DI void operator()(const f32x4 (&acc)[2][2][4][2], const Unit& u, int wr, int wc, int fr, int fq) const {
        const int row0 = u.pm * BM + wr * 64 + fr, col0 = u.pn * BM + wc * 32 + 8 * fq;
#pragma unroll
        for (int ai = 0; ai < 2; ++ai)
#pragma unroll
            for (int m = 0; m < 4; ++m) { bf16_t* rowp = O + (size_t)(row0 + ai * HALF + m * 16) * ldc + col0;
#pragma unroll
                for (int bj = 0; bj < 2; ++bj) { const f32x4 v0 = acc[ai][bj][m][0], v1 = acc[ai][bj][m][1];
                    u32x4 w; w.x = pk2(v0[0], v0[1]); w.y = pk2(v0[2], v0[3]); w.z = pk2(v1[0], v1[1]); w.w = pk2(v1[2], v1[3]);
                    *(u32x4*)(rowp + bj * HALF) = w; } }
    }
};
struct EpiUp {
    static constexpr bool PERM = true;
    bf16_t* O; int ldc; const float* rowss;
    DI void operator()(const f32x4 (&acc)[2][2][4][2], const Unit& u, int wr, int wc, int fr, int fq) const {
        const int row0 = u.pm * BM + wr * 64 + fr, col0 = u.pn * BM + wc * 32 + 8 * fq;
#pragma unroll
        for (int ai = 0; ai < 2; ++ai)
#pragma unroll
            for (int m = 0; m < 4; ++m) { const int r = row0 + ai * HALF + m * 16; bf16_t* rowp = O + (size_t)r * ldc + col0;
                const float rs = rsqrtf(rowss[r] * (1.0f / DM) + EPS);
#pragma unroll
                for (int bj = 0; bj < 2; ++bj) { f32x4 v0 = acc[ai][bj][m][0] * rs, v1 = acc[ai][bj][m][1] * rs;
#pragma unroll
                    for (int j = 0; j < 4; ++j) { const float a = fmaxf(v0[j], 0.f), b = fmaxf(v1[j], 0.f); v0[j] = a * a; v1[j] = b * b; }
                    u32x4 w; w.x = pk2(v0[0], v0[1]); w.y = pk2(v0[2], v0[3]); w.z = pk2(v1[0], v1[1]); w.w = pk2(v1[2], v1[3]);
                    *(u32x4*)(rowp + bj * HALF) = w; } }
    }
};
template <bool FIRST> struct EpiRes {
    static constexpr bool PERM = false;
    const float* xp; const float* xs; float* out; bf16_t* hb; float* rowss;
    DI void operator()(const f32x4 (&acc)[2][2][4][2], const Unit& u, int wr, int wc, int fr, int fq) const {
        const int col0 = u.pn * BM + wc * 32 + 4 * fq;
#pragma unroll
        for (int ai = 0; ai < 2; ++ai)
#pragma unroll
            for (int m = 0; m < 4; ++m) { const int r = u.pm * BM + ai * HALF + wr * 64 + m * 16 + fr;
                const float* base = FIRST ? (r < NTP ? xp + (size_t)r * DM : xs + (size_t)(r - NTP) * DM) : out + (size_t)r * DM;
                float* orow = out + (size_t)r * DM; float ss = 0.f;
#pragma unroll
                for (int bj = 0; bj < 2; ++bj)
#pragma unroll
                    for (int n = 0; n < 2; ++n) { const int c = col0 + bj * HALF + n * 16; const f32x4 o = *(const f32x4*)(base + c) + acc[ai][bj][m][n];
                        ss += (o[0] * o[0] + o[1] * o[1]) + (o[2] * o[2] + o[3] * o[3]); *(f32x4*)(orow + c) = o;
                        if (FIRST) { u32x2 w; w.x = pk2(o[0], o[1]); w.y = pk2(o[2], o[3]); *(u32x2*)(hb + (size_t)r * DM + c) = w; } }
                ss += __shfl_xor(ss, 16); ss += __shfl_xor(ss, 32);
                if (fq == 0) unsafeAtomicAdd(rowss + r, ss); }
    }
};

template <class Epi, class Sched, bool ALIGN_EPI = true>
DI void gemm_phase(LAS unsigned char* lds, const Gemm g, const Sched& S, const Epi& E) {
    const int tid = threadIdx.x, wid = __builtin_amdgcn_readfirstlane(tid >> 6), lane = tid & 63, wr = wid >> 2, wc = wid & 3, fr = lane & 15, fq = lane >> 4;
    const int K = g.K, nt = K / BK;
    unsigned voffA[2], voffB[2];
#pragma unroll
    for (int i = 0; i < 2; ++i) { int R, C; stage_rc(tid * 16 + i * 8192, R, C); const int Rb = Epi::PERM ? ((R & ~31) + perm32(R & 31)) : R;
        voffA[i] = (unsigned)(R * K + C) * 2u; voffB[i] = (unsigned)(Rb * K + C) * 2u; }
    const size_t kstep = (size_t)(BK * 2);
    const size_t hstep = (size_t)HALF * K * 2;
    const size_t tstep = 2 * hstep;
    const unsigned ldsw = (unsigned)wid * 1024u;
    const int aoff = lds_byte(wr * 64 + fr, fq * 8), boff = lds_byte(wc * 32 + fr, fq * 8);
#define PG8_SA(b, h) (((b) * 2 + (h)) * HTB)
#define PG8_SB(b, h) ((4 + (b) * 2 + (h)) * HTB)
#define PG8_STAGE(bufoff, gbase, voff) do { _Pragma("unroll") for (int _i = 0; _i < 2; ++_i) \
        __builtin_amdgcn_global_load_lds((const unsigned*)((const char*)(gbase) + (voff)[_i]), (LAS unsigned*)(lds + (bufoff) + ldsw + _i * 8192), 16, 0, 0); } while (0)
#define PG8_LDA(dst, b, h) do { _Pragma("unroll") for (int m = 0; m < 4; ++m) _Pragma("unroll") for (int k = 0; k < 2; ++k) dst[m][k] = *(const LAS bf16x8*)(lds + PG8_SA(b, h) + aoff + m * 2048 + k * 1024); } while (0)
#define PG8_LDB(dst, b, h) do { _Pragma("unroll") for (int n = 0; n < 2; ++n) _Pragma("unroll") for (int k = 0; k < 2; ++k) dst[n][k] = *(const LAS bf16x8*)(lds + PG8_SB(b, h) + boff + n * 2048 + k * 1024); } while (0)
#define PG8_MMA(ai, bj, At, Bt) do { __builtin_amdgcn_s_setprio(1); _Pragma("unroll") for (int m = 0; m < 4; ++m) _Pragma("unroll") for (int n = 0; n < 2; ++n) _Pragma("unroll") for (int k = 0; k < 2; ++k) \
        acc[ai][bj][m][n] = __builtin_amdgcn_mfma_f32_16x16x32_bf16(Bt[n][k], At[m][k], acc[ai][bj][m][n], 0, 0, 0); __builtin_amdgcn_s_setprio(0); } while (0)
#define PG8_WAIT_V(n) asm volatile("s_waitcnt vmcnt(" #n ")" ::: "memory")
#define PG8_WAIT_L(n) asm volatile("s_waitcnt lgkmcnt(" #n ")" ::: "memory")
#define PG8_BAR __builtin_amdgcn_s_barrier()
#define PG8_SCHED __builtin_amdgcn_sched_barrier(0)
    Unit cur, nxt; int ui = 0;
    if (!S.next(0, cur)) return;
    f32x4 acc[2][2][4][2];
#pragma unroll
    for (int a = 0; a < 2; ++a)
#pragma unroll
        for (int b = 0; b < 2; ++b)
#pragma unroll
            for (int m = 0; m < 4; ++m)
#pragma unroll
                for (int n = 0; n < 2; ++n) acc[a][b][m][n] = (f32x4){0.f, 0.f, 0.f, 0.f};
    bf16x8 At[4][2], B0[2][2], B1[2][2];
    const char* cA = (const char*)g.A + (size_t)cur.pm * tstep; const char* cB = (const char*)g.Bt + (size_t)cur.pn * tstep;
    PG8_STAGE(PG8_SB(0, 0), cB, voffB); PG8_STAGE(PG8_SB(0, 1), cB + hstep, voffB); PG8_STAGE(PG8_SA(0, 0), cA, voffA); PG8_STAGE(PG8_SA(0, 1), cA + hstep, voffA);
    if (wr == 1) PG8_BAR;
    PG8_WAIT_V(2); PG8_BAR;
    PG8_STAGE(PG8_SB(1, 0), cB + kstep, voffB); PG8_STAGE(PG8_SA(1, 0), cA + kstep, voffA); PG8_STAGE(PG8_SB(1, 1), cB + hstep + kstep, voffB);
    PG8_WAIT_V(6); PG8_BAR;
    for (;;) {
        const bool has_next = S.next(ui + 1, nxt);
        const char* nA = has_next ? (const char*)g.A + (size_t)nxt.pm * tstep : cA; const char* nB = has_next ? (const char*)g.Bt + (size_t)nxt.pn * tstep : cB;
        for (int t = 0; t < nt; t += 2) {
            const bool last = (t == nt - 2);
            const char* a1 = cA + (size_t)(t + 1) * kstep;
            const char* a2 = last ? nA : cA + (size_t)(t + 2) * kstep; const char* b2 = last ? nB : cB + (size_t)(t + 2) * kstep;
            const char* a3 = a2 + kstep; const char* b3 = b2 + kstep;
            PG8_LDB(B0, 0, 0); PG8_LDB(B1, 0, 1); PG8_SCHED; PG8_LDA(At, 0, 0); PG8_STAGE(PG8_SA(1, 1), a1 + hstep, voffA);
            PG8_WAIT_V(8); PG8_WAIT_L(0); PG8_BAR; PG8_MMA(0, 0, At, B0); PG8_MMA(0, 1, At, B1); PG8_BAR; PG8_SCHED;
            PG8_LDA(At, 0, 1); PG8_STAGE(PG8_SB(0, 0), b2, voffB); PG8_STAGE(PG8_SB(0, 1), b2 + hstep, voffB); PG8_STAGE(PG8_SA(0, 0), a2, voffA);
            PG8_WAIT_V(8); PG8_WAIT_L(0); PG8_BAR; PG8_MMA(1, 0, At, B0); PG8_MMA(1, 1, At, B1); PG8_BAR; PG8_SCHED;
            PG8_LDB(B0, 1, 0); PG8_LDB(B1, 1, 1); PG8_SCHED; PG8_LDA(At, 1, 0); PG8_STAGE(PG8_SA(0, 1), a2 + hstep, voffA);
            PG8_WAIT_V(8); PG8_WAIT_L(0); PG8_BAR; PG8_MMA(0, 0, At, B0); PG8_MMA(0, 1, At, B1); PG8_BAR; PG8_SCHED;
            PG8_LDA(At, 1, 1); PG8_STAGE(PG8_SB(1, 0), b3, voffB); PG8_STAGE(PG8_SB(1, 1), b3 + hstep, voffB); PG8_STAGE(PG8_SA(1, 0), a3, voffA);
            PG8_WAIT_V(8); PG8_WAIT_L(0); PG8_BAR; PG8_MMA(1, 0, At, B0); PG8_MMA(1, 1, At, B1); PG8_BAR; PG8_SCHED;
        }
        if constexpr (ALIGN_EPI) { if (wr == 0) PG8_BAR; }
        E(acc, cur, wr, wc, fr, fq);
        if (!has_next) break;
#pragma unroll
        for (int a = 0; a < 2; ++a)
#pragma unroll
            for (int b = 0; b < 2; ++b)
#pragma unroll
                for (int m = 0; m < 4; ++m)
#pragma unroll
                    for (int n = 0; n < 2; ++n) acc[a][b][m][n] = (f32x4){0.f, 0.f, 0.f, 0.f};
        cur = nxt; cA = nA; cB = nB; ++ui;
        if constexpr (ALIGN_EPI) { if (wr == 1) PG8_BAR; }
    }
    PG8_WAIT_V(0);
    if constexpr (!ALIGN_EPI) { if (wr == 0) PG8_BAR; }
    PG8_BAR;
#undef PG8_SA
#undef PG8_SB
#undef PG8_STAGE
#undef PG8_LDA
#undef PG8_LDB
#undef PG8_MMA
#undef PG8_WAIT_V
#undef PG8_WAIT_L
#undef PG8_BAR
#undef PG8_SCHED
}
}

struct Ptrs {
    const float *x_p, *x_s, *state, *ck, *cv, *ln_mix, *w_in, *lb_logits, *hg_norm, *sinks, *w_out, *ln_mlp, *w_up, *w_down, *ln_final;
    float* out;
    bf16_t *WinT, *WoutT, *WupT, *WdnT, *XN, *Z, *MIX, *U;
    float *HS, *DSC, *rss1, *rss2;
};

DI void p0_transpose_item(const float* W, int K, int N, bf16_t* WT, const float* kscale, LAS float* scr, int item, int lane) {
    const int nblk = N / 32, kb = item / nblk, nb = item % nblk, k0 = 64 * kb, n0 = 32 * nb;
#pragma unroll 8
    for (int i = 0; i < 32; ++i) { const int kk = 2 * i + (lane >> 5); float v = W[(size_t)(k0 + kk) * N + n0 + (lane & 31)]; if (kscale) v *= kscale[k0 + kk]; scr[kk * 33 + (lane & 31)] = v; }
    asm volatile("s_waitcnt lgkmcnt(0)" ::: "memory");
    const int c = lane & 7;
#pragma unroll
    for (int j = 0; j < 4; ++j) { const int n = (lane >> 3) + 8 * j; const LAS float* s = scr + (8 * c) * 33 + n;
        u32x4 o; o.x = pk2(s[0 * 33], s[1 * 33]); o.y = pk2(s[2 * 33], s[3 * 33]); o.z = pk2(s[4 * 33], s[5 * 33]); o.w = pk2(s[6 * 33], s[7 * 33]);
        *(u32x4*)(WT + (size_t)(n0 + n) * K + k0 + 8 * c) = o; }
    asm volatile("s_waitcnt lgkmcnt(0)" ::: "memory");
}
DI void p0_prologue(LAS unsigned char* lds, const Ptrs& P, int G) {
    const int tid = threadIdx.x, lane = tid & 63, wave = __builtin_amdgcn_readfirstlane(tid >> 6);
    LAS float* scr = (LAS float*)(lds + wave * 16384);
    const int gw = blockIdx.x * 8 + wave, NGW = G * 8;
    constexpr int I_IN = (DM / 64) * (NIN / 32), I_O = (DM / 64) * (DM / 32), I_UP = (DM / 64) * (FF / 32), I_DN = (FF / 64) * (DM / 32);
    constexpr int NITEMS = I_IN + I_O + I_UP + I_DN;
    for (int it = gw; it < NITEMS; it += NGW) {
        int r = it;
        if (r < I_IN) { p0_transpose_item(P.w_in, DM, NIN, P.WinT, nullptr, scr, r, lane); continue; } r -= I_IN;
        if (r < I_O) { p0_transpose_item(P.w_out, DM, DM, P.WoutT, nullptr, scr, r, lane); continue; } r -= I_O;
        if (r < I_UP) { p0_transpose_item(P.w_up, DM, FF, P.WupT, P.ln_mlp, scr, r, lane); continue; } r -= I_UP;
        p0_transpose_item(P.w_down, FF, DM, P.WdnT, nullptr, scr, r, lane);
    }
    f32x4 gv[4];
#pragma unroll
    for (int j = 0; j < 4; ++j) gv[j] = *((const f32x4*)P.ln_mix + lane + 64 * j);
    for (int m = gw; m < M; m += NGW) {
        const float* xrow = m < NTP ? P.x_p + (size_t)m * DM : P.x_s + (size_t)(m - NTP) * DM;
        const f32x4* xr = (const f32x4*)xrow + lane;
        f32x4 v[4]; float s = 0.f;
#pragma unroll
        for (int j = 0; j < 4; ++j) { v[j] = xr[64 * j]; s += (v[j].x * v[j].x + v[j].y * v[j].y) + (v[j].z * v[j].z + v[j].w * v[j].w); }
        const float rstd = rsqrtf(wave_sum(s) * (1.f / DM) + EPS);
        unsigned long long* o8 = (unsigned long long*)(P.XN + (size_t)m * DM) + lane;
#pragma unroll
        for (int j = 0; j < 4; ++j) { const f32x4 w = v[j] * rstd * gv[j]; o8[64 * j] = (unsigned long long)pk2(w.x, w.y) | ((unsigned long long)pk2(w.z, w.w) << 32); }
    }
    for (int i = blockIdx.x * 512 + tid; i < M; i += G * 512) { P.rss1[i] = 0.f; P.rss2[i] = 0.f; }
}

constexpr int HSTR = 136, HROWB = HSTR * 2;
constexpr int OFF_QT = 0, OFF_KT = 128 * HROWB, OFF_KET = 2 * 128 * HROWB, OFF_VT = 3 * 128 * HROWB, OFF_DEC = 4 * 128 * HROWB, OFF_SS = OFF_DEC + 2048;
static_assert(OFF_SS + 512 <= LDS_BYTES, "hgrn lds");
template <bool FULL>
DI void hgrn_unit(LAS unsigned char* lds, const Ptrs& P, int unit) {
    const int tid = threadIdx.x, lane = tid & 63, wid = __builtin_amdgcn_readfirstlane(tid >> 6), r32 = lane & 31, hi = lane >> 5;
    const int bh = unit >> 5, sc = unit & 31, b = bh >> 2, h = bh & 3;
    const size_t row0 = (size_t)b * SEQ + sc * 128;
    LAS float* DEC = (LAS float*)(lds + OFF_DEC);
    LAS float* SSb = (LAS float*)(lds + OFF_SS);
    {
        const int c = tid >> 7, d = tid & 127;
        const float l0 = P.lb_logits[h * 128 + d], l1 = P.lb_logits[512 + h * 128 + d];
        const float lbv = 1.f / (1.f + __expf(l1 - l0)), oml = 1.f - lbv;
        const bf16_t* zrow = P.Z + (row0 + c * 32) * NIN + h * 128 + d;
        float bcum[32], kk[32]; float cum = 0.f;
#pragma unroll
        for (int t = 0; t < 32; ++t) {
            float zf = bf2f(zrow[(size_t)t * NIN + ZF]); zf = fminf(fmaxf(zf, -30.f), 30.f);
            const float e = __expf(-zf), sg = 1.f / (1.f + e);
            const float f = lbv + oml * sg, k = oml * e * sg;
            cum += __logf(f); bcum[t] = cum; kk[t] = k;
            if (FULL) {
                const float zq = bf2f(zrow[(size_t)t * NIN + ZQ]);
                const float q = zq / (1.f + __expf(-zq));
                *(LAS bf16_t*)(lds + OFF_QT + (c * 32 + t) * HROWB + d * 2) = (bf16_t)(pk2(q * __expf(cum), 0.f) & 0xffffu);
                *(LAS bf16_t*)(lds + OFF_KT + (c * 32 + t) * HROWB + d * 2) = (bf16_t)(pk2(k * __expf(-cum), 0.f) & 0xffffu);
            }
        }
        DEC[c * 128 + d] = __expf(cum);
#pragma unroll
        for (int t8 = 0; t8 < 4; ++t8) {
            u32x4 w;
            w.x = pk2(kk[8 * t8 + 0] * __expf(cum - bcum[8 * t8 + 0]), kk[8 * t8 + 1] * __expf(cum - bcum[8 * t8 + 1]));
            w.y = pk2(kk[8 * t8 + 2] * __expf(cum - bcum[8 * t8 + 2]), kk[8 * t8 + 3] * __expf(cum - bcum[8 * t8 + 3]));
            w.z = pk2(kk[8 * t8 + 4] * __expf(cum - bcum[8 * t8 + 4]), kk[8 * t8 + 5] * __expf(cum - bcum[8 * t8 + 5]));
            w.w = pk2(kk[8 * t8 + 6] * __expf(cum - bcum[8 * t8 + 6]), kk[8 * t8 + 7] * __expf(cum - bcum[8 * t8 + 7]));
            *(LAS u32x4*)(lds + OFF_KET + d * HROWB + (c * 32 + 8 * t8) * 2) = w;
        }
#pragma unroll
        for (int t8 = 0; t8 < 4; ++t8) {
            unsigned v[8];
#pragma unroll
            for (int j = 0; j < 8; ++j) v[j] = zrow[(size_t)(8 * t8 + j) * NIN + ZI];
            u32x4 w; w.x = v[0] | (v[1] << 16); w.y = v[2] | (v[3] << 16); w.z = v[4] | (v[5] << 16); w.w = v[6] | (v[7] << 16);
            *(LAS u32x4*)(lds + OFF_VT + d * HROWB + (c * 32 + 8 * t8) * 2) = w;
        }
    }
    __syncthreads();
    const bool act = wid < 4; const int vb = wid & 3;
    f32x16 S[4];
    float* HSu = P.HS + (size_t)unit * 16384;
#pragma unroll
    for (int i = 0; i < 4; ++i)
#pragma unroll
        for (int r = 0; r < 16; ++r) S[i][r] = (FULL && act) ? HSu[(32 * i + crow(r, hi)) * 128 + vb * 32 + r32] : 0.f;
#pragma unroll 1
    for (int c = 0; c < 4; ++c) {
        f32x16 o0;
#pragma unroll
        for (int r = 0; r < 16; ++r) o0[r] = 0.f;
        if (act) {
            if (FULL) {
                f32x16 at;
#pragma unroll
                for (int r = 0; r < 16; ++r) at[r] = 0.f;
#pragma unroll
                for (int ks = 0; ks < 8; ++ks) {
                    const bf16x8 a = *(const LAS bf16x8*)(lds + OFF_KT + (c * 32 + r32) * HROWB + (ks * 16 + 8 * hi) * 2);
                    const bf16x8 bq = *(const LAS bf16x8*)(lds + OFF_QT + (c * 32 + r32) * HROWB + (ks * 16 + 8 * hi) * 2);
                    at = MFMA32(a, bq, at);
                }
#pragma unroll
                for (int r = 0; r < 16; ++r) if (crow(r, hi) > r32) at[r] = 0.f;
#pragma unroll
                for (int s2 = 0; s2 < 2; ++s2) {
                    const bf16x8 pa = packs(at, s2);
                    const LAS unsigned char* vp = lds + OFF_VT + (vb * 32 + r32) * HROWB + (c * 32 + 16 * s2 + 4 * hi) * 2;
                    const bf16x8 av = cat4(*(const LAS s16x4*)vp, *(const LAS s16x4*)(vp + 16));
                    o0 = MFMA32(av, pa, o0);
                }
#pragma unroll
                for (int i = 0; i < 4; ++i)
#pragma unroll
                    for (int s2 = 0; s2 < 2; ++s2) {
                        const bf16x8 sa = packs(S[i], s2);
                        const LAS unsigned char* qp = lds + OFF_QT + (c * 32 + r32) * HROWB + (32 * i + 16 * s2 + 4 * hi) * 2;
                        const bf16x8 bq = cat4(*(const LAS s16x4*)qp, *(const LAS s16x4*)(qp + 16));
                        o0 = MFMA32(sa, bq, o0);
                    }
            }
#pragma unroll
            for (int i = 0; i < 4; ++i) {
#pragma unroll
                for (int g4 = 0; g4 < 4; ++g4) { const f32x4 dv = *(const LAS f32x4*)(DEC + c * 128 + 32 * i + 8 * g4 + 4 * hi);
#pragma unroll
                    for (int j = 0; j < 4; ++j) S[i][4 * g4 + j] *= dv[j]; }
#pragma unroll
                for (int k2 = 0; k2 < 2; ++k2) {
                    const bf16x8 a = *(const LAS bf16x8*)(lds + OFF_KET + (32 * i + r32) * HROWB + (c * 32 + 16 * k2 + 8 * hi) * 2);
                    const bf16x8 bv = *(const LAS bf16x8*)(lds + OFF_VT + (vb * 32 + r32) * HROWB + (c * 32 + 16 * k2 + 8 * hi) * 2);
                    S[i] = MFMA32(a, bv, S[i]);
                }
            }
        }
        if (FULL) {
            if (act) { float ss = 0.f;
#pragma unroll
                for (int r = 0; r < 16; ++r) ss += o0[r] * o0[r];
                ss += __shfl_xor(ss, 32);
                if (hi == 0) SSb[wid * 32 + r32] = ss; }
            __syncthreads();
            if (act) {
                const float tot = (SSb[r32] + SSb[32 + r32]) + (SSb[64 + r32] + SSb[96 + r32]);
                const float rstd = rsqrtf(tot * (1.f / 128.f) + EPS);
                const size_t row = row0 + c * 32 + r32;
#pragma unroll
                for (int g4 = 0; g4 < 4; ++g4) {
                    const int v0 = vb * 32 + 8 * g4 + 4 * hi;
                    const u32x2 zg = *(const u32x2*)(P.Z + row * NIN + ZG + h * 128 + v0);
                    const f32x4 gn = *(const f32x4*)(P.hg_norm + v0);
                    float gz[4] = {bflo(zg.x), bfhi(zg.x), bflo(zg.y), bfhi(zg.y)}; float ov[4];
#pragma unroll
                    for (int j = 0; j < 4; ++j) ov[j] = o0[4 * g4 + j] * rstd * gn[j] * (gz[j] / (1.f + __expf(-gz[j])));
                    u32x2 w; w.x = pk2(ov[0], ov[1]); w.y = pk2(ov[2], ov[3]);
                    *(u32x2*)(P.MIX + row * DM + h * 128 + v0) = w;
                }
            }
            __syncthreads();
        }
    }
    if (!FULL) {
        if (act) {
#pragma unroll
            for (int i = 0; i < 4; ++i)
#pragma unroll
                for (int r = 0; r < 16; ++r) HSu[(32 * i + crow(r, hi)) * 128 + vb * 32 + r32] = S[i][r];
        }
        if (tid < 128) P.DSC[unit * 128 + tid] = (DEC[tid] * DEC[128 + tid]) * (DEC[256 + tid] * DEC[384 + tid]);
    }
    __syncthreads();
}

template <class MaskF>
DI void swa_tile(const LAS unsigned char* KSb, int kstrideB, const LAS unsigned char* VTb, int vstrideB, const bf16_t* qrow, float sink, MaskF valid, bf16_t* orow, int r32, int hi) {
    bf16x8 qf[4];
#pragma unroll
    for (int ks = 0; ks < 4; ++ks) qf[ks] = *(const bf16x8*)(qrow + 16 * ks + 8 * hi);
    f32x16 st[5];
#pragma unroll
    for (int kt = 0; kt < 5; ++kt) {
#pragma unroll
        for (int r = 0; r < 16; ++r) st[kt][r] = 0.f;
#pragma unroll
        for (int ks = 0; ks < 4; ++ks) { const bf16x8 a = *(const LAS bf16x8*)(KSb + (32 * kt + r32) * kstrideB + (16 * ks + 8 * hi) * 2); st[kt] = MFMA32(a, qf[ks], st[kt]); }
    }
    float m = sink;
#pragma unroll
    for (int kt = 0; kt < 5; ++kt)
#pragma unroll
        for (int r = 0; r < 16; ++r) { const int jr = 32 * kt + crow(r, hi); const float s = valid(jr) ? st[kt][r] * 0.125f : -INFINITY; st[kt][r] = s; m = fmaxf(m, s); }
    m = fmaxf(m, __shfl_xor(m, 32));
    float den = 0.f;
#pragma unroll
    for (int kt = 0; kt < 5; ++kt)
#pragma unroll
        for (int r = 0; r < 16; ++r) { const float p = __expf(st[kt][r] - m); st[kt][r] = p; den += p; }
    den += __shfl_xor(den, 32);
    den += __expf(sink - m);
    f32x16 o[2];
#pragma unroll
    for (int r = 0; r < 16; ++r) { o[0][r] = 0.f; o[1][r] = 0.f; }
#pragma unroll
    for (int kt = 0; kt < 5; ++kt)
#pragma unroll
        for (int s2 = 0; s2 < 2; ++s2) {
            const bf16x8 pb = packs(st[kt], s2);
#pragma unroll
            for (int dt = 0; dt < 2; ++dt) {
                const LAS unsigned char* vp = VTb + (32 * dt + r32) * vstrideB + (32 * kt + 16 * s2 + 4 * hi) * 2;
                const bf16x8 av = cat4(*(const LAS s16x4*)vp, *(const LAS s16x4*)(vp + 16));
                o[dt] = MFMA32(av, pb, o[dt]);
            }
        }
    const float inv = 1.f / den;
#pragma unroll
    for (int dt = 0; dt < 2; ++dt)
#pragma unroll
        for (int g4 = 0; g4 < 4; ++g4) { const int d0 = 32 * dt + 8 * g4 + 4 * hi;
            u32x2 w; w.x = pk2(o[dt][4 * g4] * inv, o[dt][4 * g4 + 1] * inv); w.y = pk2(o[dt][4 * g4 + 2] * inv, o[dt][4 * g4 + 3] * inv);
            *(u32x2*)(orow + d0) = w; }
}

constexpr int PK_STRB = 144, PV_STRB = 528, P_OFF_V = 256 * PK_STRB;
DI void swa_prompt_unit(LAS unsigned char* lds, const Ptrs& P, int unit) {
    const int tid = threadIdx.x, lane = tid & 63, wid = __builtin_amdgcn_readfirstlane(tid >> 6), r32 = lane & 31, hi = lane >> 5;
    const int kvh = unit & 1, n = (unit >> 1) & 31, b = unit >> 6;
    const long rowk0 = (long)b * SEQ + (long)(n - 1) * 128;
#pragma unroll
    for (int i = 0; i < 4; ++i) {
        const int q = tid + 512 * i, j = q >> 3, part = q & 7;
        u32x4 kv = (u32x4){0u, 0u, 0u, 0u}, vv = (u32x4){0u, 0u, 0u, 0u};
        if (n > 0 || j >= 128) { const bf16_t* zr = P.Z + (size_t)(rowk0 + j) * NIN + kvh * 64 + part * 8; kv = *(const u32x4*)(zr + ZSK); vv = *(const u32x4*)(zr + ZSV); }
        *(LAS u32x4*)(lds + j * PK_STRB + part * 16) = kv;
        LAS bf16_t* vt = (LAS bf16_t*)(lds + P_OFF_V + (part * 8) * PV_STRB + j * 2);
        const unsigned vw[4] = {vv.x, vv.y, vv.z, vv.w};
#pragma unroll
        for (int e = 0; e < 4; ++e) { vt[(2 * e) * (PV_STRB / 2)] = (bf16_t)(vw[e] & 0xffffu); vt[(2 * e + 1) * (PV_STRB / 2)] = (bf16_t)(vw[e] >> 16); }
    }
    __syncthreads();
    const int g = wid >> 1, half = wid & 1, qh = kvh * 4 + g;
    const float sink = P.sinks[qh];
    const int jmin = n == 0 ? 128 : 0;
#pragma unroll 1
    for (int sub = 0; sub < 2; ++sub) {
        const int i0 = 64 * half + 32 * sub;
        const size_t row = (size_t)b * SEQ + n * 128 + i0 + r32;
        auto valid = [=](int jr) { return (jr > r32) && (jr <= r32 + 128) && (i0 + jr >= jmin); };
        swa_tile(lds + i0 * PK_STRB, PK_STRB, lds + P_OFF_V + i0 * 2, PV_STRB, P.Z + row * NIN + ZSQ + qh * 64, sink, valid, P.MIX + row * DM + 512 + qh * 64, r32, hi);
    }
    __syncthreads();
}

constexpr int SK_STRB = 144, SV_STRB = 336, S_OFF_V = 2 * 160 * SK_STRB;
static_assert(S_OFF_V + 2 * 64 * SV_STRB <= LDS_BYTES, "swa sample lds");
DI void swa_sample_unit(LAS unsigned char* lds, const Ptrs& P, int b) {
    const int tid = threadIdx.x, lane = tid & 63, wid = __builtin_amdgcn_readfirstlane(tid >> 6), r32 = lane & 31, hi = lane >> 5;
    float* okb = P.out + O_KS + (size_t)b * 16384; float* ovb = P.out + O_VS + (size_t)b * 16384;
#pragma unroll
    for (int i = 0; i < 8; ++i) {
        const int q = tid + 512 * i, j = q >> 5, c4 = q & 31, kvh = c4 >> 4, d0 = (c4 & 15) * 4;
        const f32x4 kf = *(const f32x4*)(P.ck + (size_t)b * 16384 + j * 128 + c4 * 4);
        const f32x4 vf = *(const f32x4*)(P.cv + (size_t)b * 16384 + j * 128 + c4 * 4);
        if (j >= 8) { *(f32x4*)(okb + (j - 8) * 128 + c4 * 4) = kf; *(f32x4*)(ovb + (j - 8) * 128 + c4 * 4) = vf; }
        u32x2 kw; kw.x = pk2(kf[0], kf[1]); kw.y = pk2(kf[2], kf[3]);
        *(LAS u32x2*)(lds + (kvh * 160 + j) * SK_STRB + d0 * 2) = kw;
        const unsigned v01 = pk2(vf[0], vf[1]), v23 = pk2(vf[2], vf[3]);
        LAS bf16_t* vt = (LAS bf16_t*)(lds + S_OFF_V + (kvh * 64 + d0) * SV_STRB + j * 2);
        vt[0] = (bf16_t)(v01 & 0xffffu); vt[SV_STRB / 2] = (bf16_t)(v01 >> 16); vt[2 * (SV_STRB / 2)] = (bf16_t)(v23 & 0xffffu); vt[3 * (SV_STRB / 2)] = (bf16_t)(v23 >> 16);
    }
    for (int e = tid; e < 2048; e += 512) {
        const int isv = e >> 10, s = (e >> 7) & 7, c = e & 127, kvh = c >> 6, d = c & 63;
        const bf16_t raw = P.Z[(size_t)(NTP + b * 8 + s) * NIN + (isv ? ZSV : ZSK) + c];
        (isv ? ovb : okb)[(120 + s) * 128 + c] = bf2f(raw);
        if (isv) *(LAS bf16_t*)(lds + S_OFF_V + (kvh * 64 + d) * SV_STRB + (128 + s) * 2) = raw;
        else *(LAS bf16_t*)(lds + (kvh * 160 + 128 + s) * SK_STRB + d * 2) = raw;
    }
    for (int e = tid; e < 2 * 24 * 64; e += 512) {
        const int kvh = e / 1536, rem = e % 1536, jj = rem >> 6, d = rem & 63;
        *(LAS bf16_t*)(lds + (kvh * 160 + 136 + jj) * SK_STRB + d * 2) = 0;
        *(LAS bf16_t*)(lds + S_OFF_V + (kvh * 64 + d) * SV_STRB + (136 + jj) * 2) = 0;
    }
    __syncthreads();
    if (wid < 2) {
        const int kvh = wid, g = r32 >> 3, s = r32 & 7, qh = kvh * 4 + g;
        const size_t row = (size_t)NTP + b * 8 + s;
        auto valid = [=](int jr) { return jr < 128 ? (jr > s) : (jr - 128 <= s); };
        swa_tile(lds + kvh * 160 * SK_STRB, SK_STRB, lds + S_OFF_V + kvh * 64 * SV_STRB, SV_STRB, P.Z + row * NIN + ZSQ + qh * 64, P.sinks[qh], valid, P.MIX + row * DM + 512 + qh * 64, r32, hi);
    }
    __syncthreads();
}

DI void hgrn_sample_unit(LAS unsigned char* lds, const Ptrs& P, int unit) {
    const int tid = threadIdx.x, lane = tid & 63, wid = __builtin_amdgcn_readfirstlane(tid >> 6), hi = lane >> 5;
    const int b = unit >> 2, h = unit & 3;
    LAS float* Fs = (LAS float*)lds; LAS float* Ks = Fs + 1024; LAS float* Qs = Ks + 1024; LAS float* Vs = Qs + 1024; LAS float* Gs = Vs + 1024; LAS float* OP = Gs + 1024;
    for (int e = tid; e < 1024; e += 512) {
        const int t = e >> 7, d = e & 127;
        const bf16_t* zr = P.Z + (size_t)(NTP + b * 8 + t) * NIN + h * 128 + d;
        const float zq = bf2f(zr[ZQ]), zi = bf2f(zr[ZI]), zg = bf2f(zr[ZG]); float zf = bf2f(zr[ZF]); zf = fminf(fmaxf(zf, -30.f), 30.f);
        const float l0 = P.lb_logits[h * 128 + d], l1 = P.lb_logits[512 + h * 128 + d];
        const float lbv = 1.f / (1.f + __expf(l1 - l0)), oml = 1.f - lbv;
        const float ex = __expf(-zf), sg = 1.f / (1.f + ex);
        Fs[e] = lbv + oml * sg; Ks[e] = oml * ex * sg; Qs[e] = zq / (1.f + __expf(-zq)); Vs[e] = zi; Gs[e] = zg / (1.f + __expf(-zg));
    }
    __syncthreads();
    const int dg = tid >> 5, vq = tid & 31;
    const size_t soff = ((size_t)unit * 128 + dg * 8) * 128 + vq * 4;
    f32x4 S[8];
#pragma unroll
    for (int i = 0; i < 8; ++i) S[i] = *(const f32x4*)(P.state + soff + i * 128);
#pragma unroll 1
    for (int t = 0; t < 8; ++t) {
        const f32x4 v = *(const LAS f32x4*)(Vs + t * 128 + vq * 4); f32x4 op = (f32x4){0.f, 0.f, 0.f, 0.f};
#pragma unroll
        for (int i = 0; i < 8; ++i) { const int d = dg * 8 + i; const float f = Fs[t * 128 + d], k = Ks[t * 128 + d], q = Qs[t * 128 + d];
            S[i] = S[i] * f + v * k; op += S[i] * q; }
#pragma unroll
        for (int j = 0; j < 4; ++j) op[j] += __shfl_xor(op[j], 32);
        if (hi == 0) *(LAS f32x4*)(OP + (t * 8 + wid) * 128 + vq * 4) = op;
    }
    float* so = P.out + O_SS + soff;
#pragma unroll
    for (int i = 0; i < 8; ++i) *(f32x4*)(so + i * 128) = S[i];
    __syncthreads();
    {
        const int t = wid; float o0 = 0.f, o1 = 0.f;
#pragma unroll
        for (int w = 0; w < 8; ++w) { o0 += OP[(t * 8 + w) * 128 + lane]; o1 += OP[(t * 8 + w) * 128 + 64 + lane]; }
        const float rstd = rsqrtf(wave_sum(o0 * o0 + o1 * o1) * (1.f / 128.f) + EPS);
        bf16_t* mo = P.MIX + (size_t)(NTP + b * 8 + t) * DM + h * 128;
        mo[lane] = (bf16_t)(pk2(o0 * rstd * P.hg_norm[lane] * Gs[t * 128 + lane], 0.f) & 0xffffu);
        mo[64 + lane] = (bf16_t)(pk2(o1 * rstd * P.hg_norm[64 + lane] * Gs[t * 128 + 64 + lane], 0.f) & 0xffffu);
    }
    __syncthreads();
}

DI void scan_phase(const Ptrs& P, int G) {
    const int gt = blockIdx.x * 512 + threadIdx.x, NT = G * 512;
    for (int idx4 = gt; idx4 < 32 * 4096; idx4 += NT) {
        const int bh = idx4 >> 12, e = (idx4 & 4095) * 4, d = e >> 7;
        float* hp = P.HS + (size_t)bh * 32 * 16384 + e; const float* dp = P.DSC + bh * 32 * 128 + d;
        f32x4 S = (f32x4){0.f, 0.f, 0.f, 0.f};
#pragma unroll 1
        for (int s0 = 0; s0 < 32; s0 += 8) {
            f32x4 Hv[8]; float dv[8];
#pragma unroll
            for (int j = 0; j < 8; ++j) { Hv[j] = *(const f32x4*)(hp + (size_t)(s0 + j) * 16384); dv[j] = dp[(s0 + j) * 128]; }
#pragma unroll
            for (int j = 0; j < 8; ++j) { *(f32x4*)(hp + (size_t)(s0 + j) * 16384) = S; S = S * dv[j] + Hv[j]; }
        }
        *(f32x4*)(P.out + O_SP + (size_t)bh * 16384 + e) = S;
    }
    for (int e = gt; e < 8 * 128 * 256; e += NT) {
        const int b = e >> 15, j = (e >> 8) & 127, c = e & 255;
        const float v = bf2f(P.Z[(size_t)(b * SEQ + SEQ - 128 + j) * NIN + ZSK + c]);
        if (c < 128) P.out[O_KP + (size_t)(b * 128 + j) * 128 + c] = v; else P.out[O_VP + (size_t)(b * 128 + j) * 128 + (c - 128)] = v;
    }
}

DI void final_norm(const Ptrs& P, int G) {
    const int tid = threadIdx.x, lane = tid & 63, wave = tid >> 6;
    const int gw = blockIdx.x * 8 + wave, NGW = G * 8;
    f32x4 gv[4];
#pragma unroll
    for (int j = 0; j < 4; ++j) gv[j] = *((const f32x4*)P.ln_final + lane + 64 * j);
    for (int m = gw; m < M; m += NGW) {
        const float rstd = rsqrtf(P.rss2[m] * (1.f / DM) + EPS);
        f32x4* yr = (f32x4*)(P.out + (size_t)m * DM) + lane;
        f32x4 v[4];
#pragma unroll
        for (int j = 0; j < 4; ++j) v[j] = yr[64 * j];
#pragma unroll
        for (int j = 0; j < 4; ++j) yr[64 * j] = v[j] * rstd * gv[j];
    }
}

struct Args { const float* in[15]; float* out; unsigned char* ws; int ph_lo, ph_hi; };
constexpr int NPHASE = 9;

__global__ void __launch_bounds__(512, 2) mk_fwd(Args args) {
    extern __shared__ __attribute__((aligned(16))) unsigned char lds_raw[];
    LAS unsigned char* lds = (LAS unsigned char*)lds_raw;
    cg::grid_group grid = cg::this_grid();
    const int G = gridDim.x;
    Ptrs P;
    P.x_p = args.in[0]; P.x_s = args.in[1]; P.state = args.in[2]; P.ck = args.in[3]; P.cv = args.in[4]; P.ln_mix = args.in[5]; P.w_in = args.in[6]; P.lb_logits = args.in[7];
    P.hg_norm = args.in[8]; P.sinks = args.in[9]; P.w_out = args.in[10]; P.ln_mlp = args.in[11]; P.w_up = args.in[12]; P.w_down = args.in[13]; P.ln_final = args.in[14];
    P.out = args.out;
    unsigned char* ws = args.ws;
    P.WinT = (bf16_t*)(ws + WS_WIN); P.WoutT = (bf16_t*)(ws + WS_WOUT); P.WupT = (bf16_t*)(ws + WS_WUP); P.WdnT = (bf16_t*)(ws + WS_WDN);
    P.XN = (bf16_t*)(ws + WS_XN); P.Z = (bf16_t*)(ws + WS_Z); P.MIX = (bf16_t*)(ws + WS_MIX); P.U = (bf16_t*)(ws + WS_U);
    P.HS = (float*)(ws + WS_HS); P.DSC = (float*)(ws + WS_DSC); P.rss1 = (float*)(ws + WS_RSS1); P.rss2 = (float*)(ws + WS_RSS2);
    const int lo = args.ph_lo, hi = args.ph_hi;
#define IN(k) (lo <= (k) && (k) < hi)
#define SEAM(k) do { if (IN(k) && IN((k) + 1)) grid.sync(); } while (0)
    if (IN(0)) { p0_prologue(lds, P, G); }
    SEAM(0);
    if (IN(1)) { pg8::Gemm g{P.XN, P.WinT, M, NIN, DM}; pg8::StaticOrder S; S.init(M, NIN, G, (int)blockIdx.x); pg8::EpiZ E{P.Z, NIN};
        pg8::gemm_phase<pg8::EpiZ, pg8::StaticOrder, true>(lds, g, S, E); }
    SEAM(1);
    if (IN(2)) {
        for (int u = blockIdx.x; u < 1024; u += G) hgrn_unit<false>(lds, P, u);
        for (int u = blockIdx.x; u < 512; u += G) swa_prompt_unit(lds, P, u);
        for (int u = blockIdx.x; u < 512; u += G) hgrn_sample_unit(lds, P, u);
        for (int u = blockIdx.x; u < 128; u += G) swa_sample_unit(lds, P, u);
    }
    SEAM(2);
    if (IN(3)) { scan_phase(P, G); }
    SEAM(3);
    if (IN(4)) { for (int u = blockIdx.x; u < 1024; u += G) hgrn_unit<true>(lds, P, u); }
    SEAM(4);
    if (IN(5)) { pg8::Gemm g{P.MIX, P.WoutT, M, DM, DM}; pg8::StaticOrder S; S.init(M, DM, G, (int)blockIdx.x); pg8::EpiRes<true> E{P.x_p, P.x_s, P.out, P.XN, P.rss1};
        pg8::gemm_phase<pg8::EpiRes<true>, pg8::StaticOrder, true>(lds, g, S, E); }
    SEAM(5);
    if (IN(6)) { pg8::Gemm g{P.XN, P.WupT, M, FF, DM}; pg8::StaticOrder S; S.init(M, FF, G, (int)blockIdx.x); pg8::EpiUp E{P.U, FF, P.rss1};
        pg8::gemm_phase<pg8::EpiUp, pg8::StaticOrder, true>(lds, g, S, E); }
    SEAM(6);
    if (IN(7)) { pg8::Gemm g{P.U, P.WdnT, M, DM, FF}; pg8::StaticOrder S; S.init(M, DM, G, (int)blockIdx.x); pg8::EpiRes<false> E{nullptr, nullptr, P.out, nullptr, P.rss2};
        pg8::gemm_phase<pg8::EpiRes<false>, pg8::StaticOrder, true>(lds, g, S, E); }
    SEAM(7);
    if (IN(8)) { final_norm(P, G); }
#undef IN
#undef SEAM
}

extern "C" void kernel_launch(void* const* d_in, const int* in_sizes, int n_in, void* d_out, int out_size, void* d_ws, size_t ws_size, hipStream_t stream) {
    static int grid = 0;
    if (grid == 0) {
        if (n_in != 15 || (size_t)out_size != O_END || ws_size < WS_END) { fprintf(stderr, "kernel_launch: unexpected shapes (n_in %d out %d ws %zu)\n", n_in, out_size, ws_size); grid = -1; return; }
        int dev = 0, cus = 0, per_cu = 0;
        (void)hipGetDevice(&dev); (void)hipDeviceGetAttribute(&cus, hipDeviceAttributeMultiprocessorCount, dev);
        if (hipFuncSetAttribute((const void*)mk_fwd, hipFuncAttributeMaxDynamicSharedMemorySize, LDS_BYTES) != hipSuccess) { fprintf(stderr, "kernel_launch: hipFuncSetAttribute failed\n"); grid = -1; return; }
        if (hipOccupancyMaxActiveBlocksPerMultiprocessor(&per_cu, (const void*)mk_fwd, 512, LDS_BYTES) != hipSuccess || per_cu < 1) { fprintf(stderr, "kernel_launch: occupancy query says %d\n", per_cu); per_cu = 1; }
        (void)hipGetLastError();
        if (per_cu > 1) per_cu = 1;
        grid = cus * per_cu;
    }
    if (grid < 0) return;
    Args a{};
    for (int i = 0; i < 15; ++i) a.in[i] = (const float*)d_in[i];
    a.out = (float*)d_out; a.ws = (unsigned char*)d_ws;
#if MK_COOP
    a.ph_lo = 0; a.ph_hi = NPHASE;
    void* kargs[] = {&a};
    hipError_t e = hipLaunchCooperativeKernel((const void*)mk_fwd, dim3(grid), dim3(512), kargs, LDS_BYTES, stream);
    if (e != hipSuccess) fprintf(stderr, "cooperative launch failed: %s (grid %d)\n", hipGetErrorString(e), grid);
#else
    for (int p = 0; p < NPHASE; ++p) { a.ph_lo = p; a.ph_hi = p + 1; hipLaunchKernelGGL(mk_fwd, dim3(grid), dim3(512), LDS_BYTES, stream, a); }
#endif
}
```

```cpp
#include <hip/hip_runtime.h>
#include <hip/hip_cooperative_groups.h>
#include <cstdio>
#include <cstdint>
namespace cg = cooperative_groups;

#ifndef MK_COOP
#define MK_COOP 1
#endif
#define PROBE_P0 0
#define PROBE_P2A 0
#define PROBE_P2C 0
#define PROBE_SYNC 0

#define DI __device__ __forceinline__
#define LAS __attribute__((address_space(3)))
typedef unsigned short bf16_t;
typedef short bf16x8 __attribute__((ext_vector_type(8)));
typedef short s16x4 __attribute__((ext_vector_type(4)));
typedef float f32x4 __attribute__((ext_vector_type(4)));
typedef float f32x16 __attribute__((ext_vector_type(16)));
typedef unsigned u32x4 __attribute__((ext_vector_type(4)));
typedef unsigned u32x2 __attribute__((ext_vector_type(2)));
typedef float f32x2_t __attribute__((ext_vector_type(2)));
typedef __bf16 bf16x2_t __attribute__((ext_vector_type(2)));

DI unsigned pk2(float lo, float hi) { f32x2_t v = {lo, hi}; bf16x2_t b = __builtin_convertvector(v, bf16x2_t); return __builtin_bit_cast(unsigned, b); }
DI float bf2f(bf16_t v) { return __uint_as_float(((unsigned)v) << 16); }
DI float bflo(unsigned w) { return __uint_as_float(w << 16); }
DI float bfhi(unsigned w) { return __uint_as_float(w & 0xffff0000u); }
DI int crow(int reg, int h) { return (reg & 3) + 8 * (reg >> 2) + 4 * h; }
#define MFMA32(a, b, c) __builtin_amdgcn_mfma_f32_32x32x16_bf16((a), (b), (c), 0, 0, 0)
DI bf16x8 packs(const f32x16& x, int s) {
    u32x4 p; p.x = pk2(x[8 * s], x[8 * s + 1]); p.y = pk2(x[8 * s + 2], x[8 * s + 3]); p.z = pk2(x[8 * s + 4], x[8 * s + 5]); p.w = pk2(x[8 * s + 6], x[8 * s + 7]);
    return __builtin_bit_cast(bf16x8, p);
}
DI bf16x8 cat4(s16x4 lo, s16x4 hi) { return __builtin_shufflevector(lo, hi, 0, 1, 2, 3, 4, 5, 6, 7); }
DI float wave_sum(float v) {
#pragma unroll
    for (int o = 1; o < 64; o <<= 1) v += __shfl_xor(v, o);
    return v;
}

constexpr int DM = 1024, SEQ = 4096, NB = 8, NTP = NB * SEQ, DB = 128, DS = 8, NTS = DB * DS, M = NTP + NTS;
constexpr int NIN = 2816, FF = 4096;
constexpr int ZQ = 0, ZF = 512, ZI = 1024, ZG = 1536, ZSQ = 2048, ZSK = 2560, ZSV = 2688;
constexpr float EPS = 1e-6f;
constexpr size_t O_Y = 0, O_SP = (size_t)M * DM, O_KP = O_SP + 8 * 4 * 128 * 128, O_VP = O_KP + 8 * 128 * 128, O_SS = O_VP + 8 * 128 * 128,
                 O_KS = O_SS + (size_t)128 * 4 * 128 * 128, O_VS = O_KS + (size_t)128 * 128 * 128, O_END = O_VS + (size_t)128 * 128 * 128;
constexpr size_t MiB = 1u << 20;
constexpr size_t WS_RSS1 = 0, WS_RSS2 = 256 * 1024, WS_BAR = 512 * 1024, WS_WIN = 1 * MiB, WS_WOUT = 7 * MiB, WS_WUP = 9 * MiB, WS_WDN = 17 * MiB, WS_DSC = 25 * MiB,
                 WS_XN = 26 * MiB, WS_Z = 92 * MiB, WS_MIX = 274 * MiB, WS_HS = 340 * MiB, WS_U = 92 * MiB, WS_END = 404 * MiB;
static_assert(WS_XN + (size_t)M * DM * 2 <= WS_Z && WS_Z + (size_t)M * NIN * 2 <= WS_MIX && WS_MIX + (size_t)M * DM * 2 <= WS_HS && WS_U + (size_t)M * FF * 2 <= WS_END, "ws map");
constexpr int LDS_BYTES = 147456, LDS_MISC = 147456 - 64;

namespace pg8 {
constexpr int BM = 256, BK = 64, HALF = 128, HTB = HALF * BK * 2, STAGE_BYTES = 8 * HTB, NXCD = 8, WGM = 8;
DI int lds_byte(int r, int c) { const int st = (r >> 4) * 2 + (c >> 5), rr = r & 15, cc = c & 31, ob = rr * 64 + cc * 2; return st * 1024 + (ob ^ (((ob >> 9) & 1) << 5)); }
DI void stage_rc(int b, int& R, int& C) { const int st = b / 1024, sb = b % 1024, swz = sb ^ (((sb >> 9) & 1) << 5); R = (st >> 1) * 16 + swz / 64; C = (st & 1) * 32 + (swz % 64) / 2; }
DI int perm32(int rho) { const int n = rho >> 4, i = rho & 15; return 8 * (i >> 2) + 4 * n + (i & 3); }
struct Unit { int pm, pn; };
struct Gemm { const bf16_t* A; const bf16_t* Bt; int M, N, K; };
struct StaticOrder {
    int nM, nN, nwg, G, c;
    DI void init(int M_, int N_, int G_, int c_) { nM = M_ / BM; nN = N_ / BM; nwg = nM * nN; G = G_; c = c_; }
    DI bool next(int i, Unit& u) const {
        const long L = (long)i * G + c; if (L >= nwg) return false;
        int wgid = (int)L; { const int q = nwg / NXCD, r = nwg % NXCD, xcd = wgid % NXCD, off = wgid / NXCD; wgid = (xcd < r ? xcd * (q + 1) : r * (q + 1) + (xcd - r) * q) + off; }
        const int nig = WGM * nN, gid = wgid / nig, fm = gid * WGM, gsz = (nM - fm) < WGM ? (nM - fm) : WGM;
        u.pm = fm + ((wgid % nig) % gsz); u.pn = (wgid % nig) / gsz; return true;
    }
};
struct EpiZ {
    static constexpr bool PERM = true;
    bf16_t* O; int ldc;
    DI void operator()(const f32x4 (&acc)[2][2][4][2], const Unit& u, int wr, int wc, int fr, int fq) const {
        const int row0 = u.pm * BM + wr * 64 + fr, col0 = u.pn * BM + wc * 32 + 8 * fq;
#pragma unroll
        for (int ai = 0; ai < 2; ++ai)
#pragma unroll
            for (int m = 0; m < 4; ++m) { bf16_t* rowp = O + (size_t)(row0 + ai * HALF + m * 16) * ldc + col0;
#pragma unroll
                for (int bj = 0; bj < 2; ++bj) { const f32x4 v0 = acc[ai][bj][m][0], v1 = acc[ai][bj][m][1];
                    u32x4 w; w.x = pk2(v0[0], v0[1]); w.y = pk2(v0[2], v0[3]); w.z = pk2(v1[0], v1[1]); w.w = pk2(v1[2], v1[3]);
                    *(u32x4*)(rowp + bj * HALF) = w; } }
    }
};
struct EpiUp {
    static constexpr bool PERM = true;
    bf16_t* O; int ldc; const float* rowss;
    DI void operator()(const f32x4 (&acc)[2][2][4][2], const Unit& u, int wr, int wc, int fr, int fq) const {
        const int row0 = u.pm * BM + wr * 64 + fr, col0 = u.pn * BM + wc * 32 + 8 * fq;
#pragma unroll
        for (int ai = 0; ai < 2; ++ai)
#pragma unroll
            for (int m = 0; m < 4; ++m) { const int r = row0 + ai * HALF + m * 16; bf16_t* rowp = O + (size_t)r * ldc + col0;
                const float rs = rsqrtf(rowss[r] * (1.0f / DM) + EPS);
#pragma unroll
                for (int bj = 0; bj < 2; ++bj) { f32x4 v0 = acc[ai][bj][m][0] * rs, v1 = acc[ai][bj][m][1] * rs;
#pragma unroll
                    for (int j = 0; j < 4; ++j) { const float a = fmaxf(v0[j], 0.f), b = fmaxf(v1[j], 0.f); v0[j] = a * a; v1[j] = b * b; }
                    u32x4 w; w.x = pk2(v0[0], v0[1]); w.y = pk2(v0[2], v0[3]); w.z = pk2(v1[0], v1[1]); w.w = pk2(v1[2], v1[3]);
                    *(u32x4*)(rowp + bj * HALF) = w; } }
    }
};
template <bool FIRST> struct EpiRes {
    static constexpr bool PERM = false;
    const float* xp; const float* xs; float* out; bf16_t* hb; float* rowss;
    DI void operator()(const f32x4 (&acc)[2][2][4][2], const Unit& u, int wr, int wc, int fr, int fq) const {
        const int col0 = u.pn * BM + wc * 32 + 4 * fq;
#pragma unroll
        for (int ai = 0; ai < 2; ++ai)
#pragma unroll
            for (int m = 0; m < 4; ++m) { const int r = u.pm * BM + ai * HALF + wr * 64 + m * 16 + fr;
                const float* base = FIRST ? (r < NTP ? xp + (size_t)r * DM : xs + (size_t)(r - NTP) * DM) : out + (size_t)r * DM;
                float* orow = out + (size_t)r * DM; float ss = 0.f;
#pragma unroll
                for (int bj = 0; bj < 2; ++bj)
#pragma unroll
                    for (int n = 0; n < 2; ++n) { const int c = col0 + bj * HALF + n * 16; const f32x4 o = *(const f32x4*)(base + c) + acc[ai][bj][m][n];
                        ss += (o[0] * o[0] + o[1] * o[1]) + (o[2] * o[2] + o[3] * o[3]); *(f32x4*)(orow + c) = o;
                        if (FIRST) { u32x2 w; w.x = pk2(o[0], o[1]); w.y = pk2(o[2], o[3]); *(u32x2*)(hb + (size_t)r * DM + c) = w; } }
                ss += __shfl_xor(ss, 16); ss += __shfl_xor(ss, 32);
                if (fq == 0) unsafeAtomicAdd(rowss + r, ss); }
    }
};

template <class Epi, class Sched, bool ALIGN_EPI = true>
DI void gemm_phase(LAS unsigned char* lds, const Gemm g, const Sched& S, const Epi& E) {
    const int tid = threadIdx.x, wid = __builtin_amdgcn_readfirstlane(tid >> 6), lane = tid & 63, wr = wid >> 2, wc = wid & 3, fr = lane & 15, fq = lane >> 4;
    const int K = g.K, nt = K / BK;
    unsigned voffA[2], voffB[2];
#pragma unroll
    for (int i = 0; i < 2; ++i) { int R, C; stage_rc(tid * 16 + i * 8192, R, C); const int Rb = Epi::PERM ? ((R & ~31) + perm32(R & 31)) : R;
        voffA[i] = (unsigned)(R * K + C) * 2u; voffB[i] = (unsigned)(Rb * K + C) * 2u; }
    const size_t kstep = (size_t)(BK * 2);
    const size_t hstep = (size_t)HALF * K * 2;
    const size_t tstep = 2 * hstep;
    const unsigned ldsw = (unsigned)wid * 1024u;
    const int aoff = lds_byte(wr * 64 + fr, fq * 8), boff = lds_byte(wc * 32 + fr, fq * 8);
#define PG8_SA(b, h) (((b) * 2 + (h)) * HTB)
#define PG8_SB(b, h) ((4 + (b) * 2 + (h)) * HTB)
#define PG8_STAGE(bufoff, gbase, voff) do { _Pragma("unroll") for (int _i = 0; _i < 2; ++_i) \
        __builtin_amdgcn_global_load_lds((const unsigned*)((const char*)(gbase) + (voff)[_i]), (LAS unsigned*)(lds + (bufoff) + ldsw + _i * 8192), 16, 0, 0); } while (0)
#define PG8_LDA(dst, b, h) do { _Pragma("unroll") for (int m = 0; m < 4; ++m) _Pragma("unroll") for (int k = 0; k < 2; ++k) dst[m][k] = *(const LAS bf16x8*)(lds + PG8_SA(b, h) + aoff + m * 2048 + k * 1024); } while (0)
#define PG8_LDB(dst, b, h) do { _Pragma("unroll") for (int n = 0; n < 2; ++n) _Pragma("unroll") for (int k = 0; k < 2; ++k) dst[n][k] = *(const LAS bf16x8*)(lds + PG8_SB(b, h) + boff + n * 2048 + k * 1024); } while (0)
#define PG8_MMA(ai, bj, At, Bt) do { __builtin_amdgcn_s_setprio(1); _Pragma("unroll") for (int m = 0; m < 4; ++m) _Pragma("unroll") for (int n = 0; n < 2; ++n) _Pragma("unroll") for (int k = 0; k < 2; ++k) \
        acc[ai][bj][m][n] = __builtin_amdgcn_mfma_f32_16x16x32_bf16(Bt[n][k], At[m][k], acc[ai][bj][m][n], 0, 0, 0); __builtin_amdgcn_s_setprio(0); } while (0)
#define PG8_WAIT_V(n) asm volatile("s_waitcnt vmcnt(" #n ")" ::: "memory")
#define PG8_WAIT_L(n) asm volatile("s_waitcnt lgkmcnt(" #n ")" ::: "memory")
#define PG8_BAR __builtin_amdgcn_s_barrier()
#define PG8_SCHED __builtin_amdgcn_sched_barrier(0)
    Unit cur, nxt; int ui = 0;
    if (!S.next(0, cur)) return;
    f32x4 acc[2][2][4][2];
#pragma unroll
    for (int a = 0; a < 2; ++a)
#pragma unroll
        for (int b = 0; b < 2; ++b)
#pragma unroll
            for (int m = 0; m < 4; ++m)
#pragma unroll
                for (int n = 0; n < 2; ++n) acc[a][b][m][n] = (f32x4){0.f, 0.f, 0.f, 0.f};
    bf16x8 At[4][2], B0[2][2], B1[2][2];
    const char* cA = (const char*)g.A + (size_t)cur.pm * tstep; const char* cB = (const char*)g.Bt + (size_t)cur.pn * tstep;
    PG8_STAGE(PG8_SB(0, 0), cB, voffB); PG8_STAGE(PG8_SB(0, 1), cB + hstep, voffB); PG8_STAGE(PG8_SA(0, 0), cA, voffA); PG8_STAGE(PG8_SA(0, 1), cA + hstep, voffA);
    if (wr == 1) PG8_BAR;
    PG8_WAIT_V(2); PG8_BAR;
    PG8_STAGE(PG8_SB(1, 0), cB + kstep, voffB); PG8_STAGE(PG8_SA(1, 0), cA + kstep, voffA); PG8_STAGE(PG8_SB(1, 1), cB + hstep + kstep, voffB);
    PG8_WAIT_V(6); PG8_BAR;
    for (;;) {
        const bool has_next = S.next(ui + 1, nxt);
        const char* nA = has_next ? (const char*)g.A + (size_t)nxt.pm * tstep : cA; const char* nB = has_next ? (const char*)g.Bt + (size_t)nxt.pn * tstep : cB;
        for (int t = 0; t < nt; t += 2) {
            const bool last = (t == nt - 2);
            const char* a1 = cA + (size_t)(t + 1) * kstep;
            const char* a2 = last ? nA : cA + (size_t)(t + 2) * kstep; const char* b2 = last ? nB : cB + (size_t)(t + 2) * kstep;
            const char* a3 = a2 + kstep; const char* b3 = b2 + kstep;
            PG8_LDB(B0, 0, 0); PG8_LDB(B1, 0, 1); PG8_SCHED; PG8_LDA(At, 0, 0); PG8_STAGE(PG8_SA(1, 1), a1 + hstep, voffA);
            PG8_WAIT_V(8); PG8_WAIT_L(0); PG8_BAR; PG8_MMA(0, 0, At, B0); PG8_MMA(0, 1, At, B1); PG8_BAR; PG8_SCHED;
            PG8_LDA(At, 0, 1); PG8_STAGE(PG8_SB(0, 0), b2, voffB); PG8_STAGE(PG8_SB(0, 1), b2 + hstep, voffB); PG8_STAGE(PG8_SA(0, 0), a2, voffA);
            PG8_WAIT_V(8); PG8_WAIT_L(0); PG8_BAR; PG8_MMA(1, 0, At, B0); PG8_MMA(1, 1, At, B1); PG8_BAR; PG8_SCHED;
            PG8_LDB(B0, 1, 0); PG8_LDB(B1, 1, 1); PG8_SCHED; PG8_LDA(At, 1, 0); PG8_STAGE(PG8_SA(0, 1), a2 + hstep, voffA);
            PG8_WAIT_V(8); PG8_WAIT_L(0); PG8_BAR; PG8_MMA(0, 0, At, B0); PG8_MMA(0, 1, At, B1); PG8_BAR; PG8_SCHED;
            PG8_LDA(At, 1, 1); PG8_STAGE(PG8_SB(1, 0), b3, voffB); PG8_STAGE(PG8_SB(1, 1), b3 + hstep, voffB); PG8_STAGE(PG8_SA(1, 0), a3, voffA);
            PG8_WAIT_V(8); PG8_WAIT_L(0); PG8_BAR; PG8_MMA(1, 0, At, B0); PG8_MMA(1, 1, At, B1); PG8_BAR; PG8_SCHED;
        }
        if constexpr (ALIGN_EPI) { if (wr == 0) PG8_BAR; }
        E(acc, cur, wr, wc, fr, fq);
        if (!has_next) break;
#pragma unroll
        for (int a = 0; a < 2; ++a)
#pragma unroll
            for (int b = 0; b < 2; ++b)
#pragma unroll
                for (int m = 0; m < 4; ++m)
#pragma unroll
                    for (int n = 0; n < 2; ++n) acc[a][b][m][n] = (f32x4){0.f, 0.f, 0.f, 0.f};
        cur = nxt; cA = nA; cB = nB; ++ui;
        if constexpr (ALIGN_EPI) { if (wr == 1) PG8_BAR; }
    }
    PG8_WAIT_V(0);
    if constexpr (!ALIGN_EPI) { if (wr == 0) PG8_BAR; }
    PG8_BAR;
#undef PG8_SA
#undef PG8_SB
#undef PG8_STAGE
#undef PG8_LDA
#undef PG8_LDB
#undef PG8_MMA
#undef PG8_WAIT_V
#undef PG8_WAIT_L
#undef PG8_BAR
#undef PG8_SCHED
}
}

struct Ptrs {
    const float *x_p, *x_s, *state, *ck, *cv, *ln_mix, *w_in, *lb_logits, *hg_norm, *sinks, *w_out, *ln_mlp, *w_up, *w_down, *ln_final;
    float* out;
    bf16_t *WinT, *WoutT, *WupT, *WdnT, *XN, *Z, *MIX, *U;
    float *HS, *DSC, *rss1, *rss2;
};

DI void p0_transpose_item(const float* W, int K, int N, bf16_t* WT, const float* kscale, LAS float* scr, int item, int lane) {
    const int nblk = N / 32, kb = item / nblk, nb = item % nblk, k0 = 64 * kb, n0 = 32 * nb;
#pragma unroll 8
    for (int i = 0; i < 32; ++i) { const int kk = 2 * i + (lane >> 5); float v = W[(size_t)(k0 + kk) * N + n0 + (lane & 31)]; if (kscale) v *= kscale[k0 + kk]; scr[kk * 33 + (lane & 31)] = v; }
    asm volatile("s_waitcnt lgkmcnt(0)" ::: "memory");
    const int c = lane & 7;
#pragma unroll
    for (int j = 0; j < 4; ++j) { const int n = (lane >> 3) + 8 * j; const LAS float* s = scr + (8 * c) * 33 + n;
        u32x4 o; o.x = pk2(s[0 * 33], s[1 * 33]); o.y = pk2(s[2 * 33], s[3 * 33]); o.z = pk2(s[4 * 33], s[5 * 33]); o.w = pk2(s[6 * 33], s[7 * 33]);
        *(u32x4*)(WT + (size_t)(n0 + n) * K + k0 + 8 * c) = o; }
    asm volatile("s_waitcnt lgkmcnt(0)" ::: "memory");
}
DI void p0_prologue(LAS unsigned char* lds, const Ptrs& P, int G) {
    const int tid = threadIdx.x, lane = tid & 63, wave = __builtin_amdgcn_readfirstlane(tid >> 6);
    LAS float* scr = (LAS float*)(lds + wave * 16384);
    const int gw = blockIdx.x * 8 + wave, NGW = G * 8;
    constexpr int I_IN = (DM / 64) * (NIN / 32), I_O = (DM / 64) * (DM / 32), I_UP = (DM / 64) * (FF / 32), I_DN = (FF / 64) * (DM / 32);
    constexpr int NITEMS = I_IN + I_O + I_UP + I_DN;
    for (int it = gw; it < NITEMS; it += NGW) {
        int r = it;
        if (r < I_IN) { p0_transpose_item(P.w_in, DM, NIN, P.WinT, nullptr, scr, r, lane); continue; } r -= I_IN;
        if (r < I_O) { p0_transpose_item(P.w_out, DM, DM, P.WoutT, nullptr, scr, r, lane); continue; } r -= I_O;
        if (r < I_UP) { p0_transpose_item(P.w_up, DM, FF, P.WupT, P.ln_mlp, scr, r, lane); continue; } r -= I_UP;
        p0_transpose_item(P.w_down, FF, DM, P.WdnT, nullptr, scr, r, lane);
    }
    f32x4 gv[4];
#pragma unroll
    for (int j = 0; j < 4; ++j) gv[j] = *((const f32x4*)P.ln_mix + lane + 64 * j);
    for (int m = gw; m < M; m += NGW) {
        const float* xrow = m < NTP ? P.x_p + (size_t)m * DM : P.x_s + (size_t)(m - NTP) * DM;
        const f32x4* xr = (const f32x4*)xrow + lane;
        f32x4 v[4]; float s = 0.f;
#pragma unroll
        for (int j = 0; j < 4; ++j) { v[j] = xr[64 * j]; s += (v[j].x * v[j].x + v[j].y * v[j].y) + (v[j].z * v[j].z + v[j].w * v[j].w); }
        const float rstd = rsqrtf(wave_sum(s) * (1.f / DM) + EPS);
        unsigned long long* o8 = (unsigned long long*)(P.XN + (size_t)m * DM) + lane;
#pragma unroll
        for (int j = 0; j < 4; ++j) { const f32x4 w = v[j] * rstd * gv[j]; o8[64 * j] = (unsigned long long)pk2(w.x, w.y) | ((unsigned long long)pk2(w.z, w.w) << 32); }
    }
    for (int i = blockIdx.x * 512 + tid; i < M; i += G * 512) { P.rss1[i] = 0.f; P.rss2[i] = 0.f; }
}

constexpr int HSTR = 136, HROWB = HSTR * 2;
constexpr int OFF_QT = 0, OFF_KT = 128 * HROWB, OFF_KET = 2 * 128 * HROWB, OFF_VT = 3 * 128 * HROWB, OFF_DEC = 4 * 128 * HROWB, OFF_SS = OFF_DEC + 2048;
static_assert(OFF_SS + 512 <= LDS_BYTES, "hgrn lds");
template <bool FULL>
DI void hgrn_unit(LAS unsigned char* lds, const Ptrs& P, int unit) {
    const int tid = threadIdx.x, lane = tid & 63, wid = __builtin_amdgcn_readfirstlane(tid >> 6), r32 = lane & 31, hi = lane >> 5;
    const int bh = unit >> 5, sc = unit & 31, b = bh >> 2, h = bh & 3;
    const size_t row0 = (size_t)b * SEQ + sc * 128;
    LAS float* DEC = (LAS float*)(lds + OFF_DEC);
    LAS float* SSb = (LAS float*)(lds + OFF_SS);
    {
        const int c = tid >> 7, d = tid & 127;
        const float l0 = P.lb_logits[h * 128 + d], l1 = P.lb_logits[512 + h * 128 + d];
        const float lbv = 1.f / (1.f + __expf(l1 - l0)), oml = 1.f - lbv;
        const bf16_t* zrow = P.Z + (row0 + c * 32) * NIN + h * 128 + d;
        float bcum[32], kk[32]; float cum = 0.f;
#pragma unroll
        for (int t = 0; t < 32; ++t) {
            float zf = bf2f(zrow[(size_t)t * NIN + ZF]); zf = fminf(fmaxf(zf, -30.f), 30.f);
            const float e = __expf(-zf), sg = 1.f / (1.f + e);
            const float f = lbv + oml * sg, k = oml * e * sg;
            cum += __logf(f); bcum[t] = cum; kk[t] = k;
            if (FULL) {
                const float zq = bf2f(zrow[(size_t)t * NIN + ZQ]);
                const float q = zq / (1.f + __expf(-zq));
                *(LAS bf16_t*)(lds + OFF_QT + (c * 32 + t) * HROWB + d * 2) = (bf16_t)(pk2(q * __expf(cum), 0.f) & 0xffffu);
                *(LAS bf16_t*)(lds + OFF_KT + (c * 32 + t) * HROWB + d * 2) = (bf16_t)(pk2(k * __expf(-cum), 0.f) & 0xffffu);
            }
        }
        DEC[c * 128 + d] = __expf(cum);
#pragma unroll
        for (int t8 = 0; t8 < 4; ++t8) {
            u32x4 w;
            w.x = pk2(kk[8 * t8 + 0] * __expf(cum - bcum[8 * t8 + 0]), kk[8 * t8 + 1] * __expf(cum - bcum[8 * t8 + 1]));
            w.y = pk2(kk[8 * t8 + 2] * __expf(cum - bcum[8 * t8 + 2]), kk[8 * t8 + 3] * __expf(cum - bcum[8 * t8 + 3]));
            w.z = pk2(kk[8 * t8 + 4] * __expf(cum - bcum[8 * t8 + 4]), kk[8 * t8 + 5] * __expf(cum - bcum[8 * t8 + 5]));
            w.w = pk2(kk[8 * t8 + 6] * __expf(cum - bcum[8 * t8 + 6]), kk[8 * t8 + 7] * __expf(cum - bcum[8 * t8 + 7]));
            *(LAS u32x4*)(lds + OFF_KET + d * HROWB + (c * 32 + 8 * t8) * 2) = w;
        }
#pragma unroll
        for (int t8 = 0; t8 < 4; ++t8) {
            unsigned v[8];
#pragma unroll
            for (int j = 0; j < 8; ++j) v[j] = zrow[(size_t)(8 * t8 + j) * NIN + ZI];
            u32x4 w; w.x = v[0] | (v[1] << 16); w.y = v[2] | (v[3] << 16); w.z = v[4] | (v[5] << 16); w.w = v[6] | (v[7] << 16);
            *(LAS u32x4*)(lds + OFF_VT + d * HROWB + (c * 32 + 8 * t8) * 2) = w;
        }
    }
    __syncthreads();
    const bool act = wid < 4; const int vb = wid & 3;
    f32x16 S[4];
    float* HSu = P.HS + (size_t)unit * 16384;
#pragma unroll
    for (int i = 0; i < 4; ++i)
#pragma unroll
        for (int r = 0; r < 16; ++r) S[i][r] = (FULL && act) ? HSu[(32 * i + crow(r, hi)) * 128 + vb * 32 + r32] : 0.f;
#pragma unroll 1
    for (int c = 0; c < 4; ++c) {
        f32x16 o0;
#pragma unroll
        for (int r = 0; r < 16; ++r) o0[r] = 0.f;
        if (act) {
            if (FULL) {
                f32x16 at;
#pragma unroll
                for (int r = 0; r < 16; ++r) at[r] = 0.f;
#pragma unroll
                for (int ks = 0; ks < 8; ++ks) {
                    const bf16x8 a = *(const LAS bf16x8*)(lds + OFF_KT + (c * 32 + r32) * HROWB + (ks * 16 + 8 * hi) * 2);
                    const bf16x8 bq = *(const LAS bf16x8*)(lds + OFF_QT + (c * 32 + r32) * HROWB + (ks * 16 + 8 * hi) * 2);
                    at = MFMA32(a, bq, at);
                }
#pragma unroll
                for (int r = 0; r < 16; ++r) if (crow(r, hi) > r32) at[r] = 0.f;
#pragma unroll
                for (int s2 = 0; s2 < 2; ++s2) {
                    const bf16x8 pa = packs(at, s2);
                    const LAS unsigned char* vp = lds + OFF_VT + (vb * 32 + r32) * HROWB + (c * 32 + 16 * s2 + 4 * hi) * 2;
                    const bf16x8 av = cat4(*(const LAS s16x4*)vp, *(const LAS s16x4*)(vp + 16));
                    o0 = MFMA32(av, pa, o0);
                }
#pragma unroll
                for (int i = 0; i < 4; ++i)
#pragma unroll
                    for (int s2 = 0; s2 < 2; ++s2) {
                        const bf16x8 sa = packs(S[i], s2);
                        const LAS unsigned char* qp = lds + OFF_QT + (c * 32 + r32) * HROWB + (32 * i + 16 * s2 + 4 * hi) * 2;
                        const bf16x8 bq = cat4(*(const LAS s16x4*)qp, *(const LAS s16x4*)(qp + 16));
                        o0 = MFMA32(sa, bq, o0);
                    }
            }
#pragma unroll
            for (int i = 0; i < 4; ++i) {
#pragma unroll
                for (int g4 = 0; g4 < 4; ++g4) { const f32x4 dv = *(const LAS f32x4*)(DEC + c * 128 + 32 * i + 8 * g4 + 4 * hi);
#pragma unroll
                    for (int j = 0; j < 4; ++j) S[i][4 * g4 + j] *= dv[j]; }
#pragma unroll
                for (int k2 = 0; k2 < 2; ++k2) {
                    const bf16x8 a = *(const LAS bf16x8*)(lds + OFF_KET + (32 * i + r32) * HROWB + (c * 32 + 16 * k2 + 8 * hi) * 2);
                    const bf16x8 bv = *(const LAS bf16x8*)(lds + OFF_VT + (vb * 32 + r32) * HROWB + (c * 32 + 16 * k2 + 8 * hi) * 2);
                    S[i] = MFMA32(a, bv, S[i]);
                }
            }
        }
        if (FULL) {
            if (act) { float ss = 0.f;
#pragma unroll
                for (int r = 0; r < 16; ++r) ss += o0[r] * o0[r];
                ss += __shfl_xor(ss, 32);
                if (hi == 0) SSb[wid * 32 + r32] = ss; }
            __syncthreads();
            if (act) {
                const float tot = (SSb[r32] + SSb[32 + r32]) + (SSb[64 + r32] + SSb[96 + r32]);
                const float rstd = rsqrtf(tot * (1.f / 128.f) + EPS);
                const size_t row = row0 + c * 32 + r32;
#pragma unroll
                for (int g4 = 0; g4 < 4; ++g4) {
                    const int v0 = vb * 32 + 8 * g4 + 4 * hi;
                    const u32x2 zg = *(const u32x2*)(P.Z + row * NIN + ZG + h * 128 + v0);
                    const f32x4 gn = *(const f32x4*)(P.hg_norm + v0);
                    float gz[4] = {bflo(zg.x), bfhi(zg.x), bflo(zg.y), bfhi(zg.y)}; float ov[4];
#pragma unroll
                    for (int j = 0; j < 4; ++j) ov[j] = o0[4 * g4 + j] * rstd * gn[j] * (gz[j] / (1.f + __expf(-gz[j])));
                    u32x2 w; w.x = pk2(ov[0], ov[1]); w.y = pk2(ov[2], ov[3]);
                    *(u32x2*)(P.MIX + row * DM + h * 128 + v0) = w;
                }
            }
            __syncthreads();
        }
    }
    if (!FULL) {
        if (act) {
#pragma unroll
            for (int i = 0; i < 4; ++i)
#pragma unroll
                for (int r = 0; r < 16; ++r) HSu[(32 * i + crow(r, hi)) * 128 + vb * 32 + r32] = S[i][r];
        }
        if (tid < 128) P.DSC[unit * 128 + tid] = (DEC[tid] * DEC[128 + tid]) * (DEC[256 + tid] * DEC[384 + tid]);
    }
    __syncthreads();
}

template <class MaskF>
DI void swa_tile(const LAS unsigned char* KSb, int kstrideB, const LAS unsigned char* VTb, int vstrideB, const bf16_t* qrow, float sink, MaskF valid, bf16_t* orow, int r32, int hi) {
    bf16x8 qf[4];
#pragma unroll
    for (int ks = 0; ks < 4; ++ks) qf[ks] = *(const bf16x8*)(qrow + 16 * ks + 8 * hi);
    f32x16 st[5];
#pragma unroll
    for (int kt = 0; kt < 5; ++kt) {
#pragma unroll
        for (int r = 0; r < 16; ++r) st[kt][r] = 0.f;
#pragma unroll
        for (int ks = 0; ks < 4; ++ks) { const bf16x8 a = *(const LAS bf16x8*)(KSb + (32 * kt + r32) * kstrideB + (16 * ks + 8 * hi) * 2); st[kt] = MFMA32(a, qf[ks], st[kt]); }
    }
    float m = sink;
#pragma unroll
    for (int kt = 0; kt < 5; ++kt)
#pragma unroll
        for (int r = 0; r < 16; ++r) { const int jr = 32 * kt + crow(r, hi); const float s = valid(jr) ? st[kt][r] * 0.125f : -INFINITY; st[kt][r] = s; m = fmaxf(m, s); }
    m = fmaxf(m, __shfl_xor(m, 32));
    float den = 0.f;
#pragma unroll
    for (int kt = 0; kt < 5; ++kt)
#pragma unroll
        for (int r = 0; r < 16; ++r) { const float p = __expf(st[kt][r] - m); st[kt][r] = p; den += p; }
    den += __shfl_xor(den, 32);
    den += __expf(sink - m);
    f32x16 o[2];
#pragma unroll
    for (int r = 0; r < 16; ++r) { o[0][r] = 0.f; o[1][r] = 0.f; }
#pragma unroll
    for (int kt = 0; kt < 5; ++kt)
#pragma unroll
        for (int s2 = 0; s2 < 2; ++s2) {
            const bf16x8 pb = packs(st[kt], s2);
#pragma unroll
            for (int dt = 0; dt < 2; ++dt) {
                const LAS unsigned char* vp = VTb + (32 * dt + r32) * vstrideB + (32 * kt + 16 * s2 + 4 * hi) * 2;
                const bf16x8 av = cat4(*(const LAS s16x4*)vp, *(const LAS s16x4*)(vp + 16));
                o[dt] = MFMA32(av, pb, o[dt]);
            }
        }
    const float inv = 1.f / den;
#pragma unroll
    for (int dt = 0; dt < 2; ++dt)
#pragma unroll
        for (int g4 = 0; g4 < 4; ++g4) { const int d0 = 32 * dt + 8 * g4 + 4 * hi;
            u32x2 w; w.x = pk2(o[dt][4 * g4] * inv, o[dt][4 * g4 + 1] * inv); w.y = pk2(o[dt][4 * g4 + 2] * inv, o[dt][4 * g4 + 3] * inv);
            *(u32x2*)(orow + d0) = w; }
}

constexpr int PK_STRB = 144, PV_STRB = 528, P_OFF_V = 256 * PK_STRB;
DI void swa_prompt_unit(LAS unsigned char* lds, const Ptrs& P, int unit) {
    const int tid = threadIdx.x, lane = tid & 63, wid = __builtin_amdgcn_readfirstlane(tid >> 6), r32 = lane & 31, hi = lane >> 5;
    const int kvh = unit & 1, n = (unit >> 1) & 31, b = unit >> 6;
    const long rowk0 = (long)b * SEQ + (long)(n - 1) * 128;
#pragma unroll
    for (int i = 0; i < 4; ++i) {
        const int q = tid + 512 * i, j = q >> 3, part = q & 7;
        u32x4 kv = (u32x4){0u, 0u, 0u, 0u}, vv = (u32x4){0u, 0u, 0u, 0u};
        if (n > 0 || j >= 128) { const bf16_t* zr = P.Z + (size_t)(rowk0 + j) * NIN + kvh * 64 + part * 8; kv = *(const u32x4*)(zr + ZSK); vv = *(const u32x4*)(zr + ZSV); }
        *(LAS u32x4*)(lds + j * PK_STRB + part * 16) = kv;
        LAS bf16_t* vt = (LAS bf16_t*)(lds + P_OFF_V + (part * 8) * PV_STRB + j * 2);
        const unsigned vw[4] = {vv.x, vv.y, vv.z, vv.w};
#pragma unroll
        for (int e = 0; e < 4; ++e) { vt[(2 * e) * (PV_STRB / 2)] = (bf16_t)(vw[e] & 0xffffu); vt[(2 * e + 1) * (PV_STRB / 2)] = (bf16_t)(vw[e] >> 16); }
    }
    __syncthreads();
    const int g = wid >> 1, half = wid & 1, qh = kvh * 4 + g;
    const float sink = P.sinks[qh];
    const int jmin = n == 0 ? 128 : 0;
#pragma unroll 1
    for (int sub = 0; sub < 2; ++sub) {
        const int i0 = 64 * half + 32 * sub;
        const size_t row = (size_t)b * SEQ + n * 128 + i0 + r32;
        auto valid = [=](int jr) { return (jr > r32) && (jr <= r32 + 128) && (i0 + jr >= jmin); };
        swa_tile(lds + i0 * PK_STRB, PK_STRB, lds + P_OFF_V + i0 * 2, PV_STRB, P.Z + row * NIN + ZSQ + qh * 64, sink, valid, P.MIX + row * DM + 512 + qh * 64, r32, hi);
    }
    __syncthreads();
}

constexpr int SK_STRB = 144, SV_STRB = 336, S_OFF_V = 2 * 160 * SK_STRB;
static_assert(S_OFF_V + 2 * 64 * SV_STRB <= LDS_BYTES, "swa sample lds");
DI void swa_sample_unit(LAS unsigned char* lds, const Ptrs& P, int b) {
    const int tid = threadIdx.x, lane = tid & 63, wid = __builtin_amdgcn_readfirstlane(tid >> 6), r32 = lane & 31, hi = lane >> 5;
    float* okb = P.out + O_KS + (size_t)b * 16384; float* ovb = P.out + O_VS + (size_t)b * 16384;
#pragma unroll
    for (int i = 0; i < 8; ++i) {
        const int q = tid + 512 * i, j = q >> 5, c4 = q & 31, kvh = c4 >> 4, d0 = (c4 & 15) * 4;
        const f32x4 kf = *(const f32x4*)(P.ck + (size_t)b * 16384 + j * 128 + c4 * 4);
        const f32x4 vf = *(const f32x4*)(P.cv + (size_t)b * 16384 + j * 128 + c4 * 4);
        if (j >= 8) { *(f32x4*)(okb + (j - 8) * 128 + c4 * 4) = kf; *(f32x4*)(ovb + (j - 8) * 128 + c4 * 4) = vf; }
        u32x2 kw; kw.x = pk2(kf[0], kf[1]); kw.y = pk2(kf[2], kf[3]);
        *(LAS u32x2*)(lds + (kvh * 160 + j) * SK_STRB + d0 * 2) = kw;
        const unsigned v01 = pk2(vf[0], vf[1]), v23 = pk2(vf[2], vf[3]);
        LAS bf16_t* vt = (LAS bf16_t*)(lds + S_OFF_V + (kvh * 64 + d0) * SV_STRB + j * 2);
        vt[0] = (bf16_t)(v01 & 0xffffu); vt[SV_STRB / 2] = (bf16_t)(v01 >> 16); vt[2 * (SV_STRB / 2)] = (bf16_t)(v23 & 0xffffu); vt[3 * (SV_STRB / 2)] = (bf16_t)(v23 >> 16);
    }
    for (int e = tid; e < 2048; e += 512) {
        const int isv = e >> 10, s = (e >> 7) & 7, c = e & 127, kvh = c >> 6, d = c & 63;
        const bf16_t raw = P.Z[(size_t)(NTP + b * 8 + s) * NIN + (isv ? ZSV : ZSK) + c];
        (isv ? ovb : okb)[(120 + s) * 128 + c] = bf2f(raw);
        if (isv) *(LAS bf16_t*)(lds + S_OFF_V + (kvh * 64 + d) * SV_STRB + (128 + s) * 2) = raw;
        else *(LAS bf16_t*)(lds + (kvh * 160 + 128 + s) * SK_STRB + d * 2) = raw;
    }
    for (int e = tid; e < 2 * 24 * 64; e += 512) {
        const int kvh = e / 1536, rem = e % 1536, jj = rem >> 6, d = rem & 63;
        *(LAS bf16_t*)(lds + (kvh * 160 + 136 + jj) * SK_STRB + d * 2) = 0;
        *(LAS bf16_t*)(lds + S_OFF_V + (kvh * 64 + d) * SV_STRB + (136 + jj) * 2) = 0;
    }
    __syncthreads();
    if (wid < 2) {
        const int kvh = wid, g = r32 >> 3, s = r32 & 7, qh = kvh * 4 + g;
        const size_t row = (size_t)NTP + b * 8 + s;
        auto valid = [=](int jr) { return jr < 128 ? (jr > s) : (jr - 128 <= s); };
        swa_tile(lds + kvh * 160 * SK_STRB, SK_STRB, lds + S_OFF_V + kvh * 64 * SV_STRB, SV_STRB, P.Z + row * NIN + ZSQ + qh * 64, P.sinks[qh], valid, P.MIX + row * DM + 512 + qh * 64, r32, hi);
    }
    __syncthreads();
}

DI void hgrn_sample_unit(LAS unsigned char* lds, const Ptrs& P, int unit) {
    const int tid = threadIdx.x, lane = tid & 63, wid = __builtin_amdgcn_readfirstlane(tid >> 6), hi = lane >> 5;
    const int b = unit >> 2, h = unit & 3;
    LAS float* Fs = (LAS float*)lds; LAS float* Ks = Fs + 1024; LAS float* Qs = Ks + 1024; LAS float* Vs = Qs + 1024; LAS float* Gs = Vs + 1024; LAS float* OP = Gs + 1024;
    for (int e = tid; e < 1024; e += 512) {
        const int t = e >> 7, d = e & 127;
        const bf16_t* zr = P.Z + (size_t)(NTP + b * 8 + t) * NIN + h * 128 + d;
        const float zq = bf2f(zr[ZQ]), zi = bf2f(zr[ZI]), zg = bf2f(zr[ZG]); float zf = bf2f(zr[ZF]); zf = fminf(fmaxf(zf, -30.f), 30.f);
        const float l0 = P.lb_logits[h * 128 + d], l1 = P.lb_logits[512 + h * 128 + d];
        const float lbv = 1.f / (1.f + __expf(l1 - l0)), oml = 1.f - lbv;
        const float ex = __expf(-zf), sg = 1.f / (1.f + ex);
        Fs[e] = lbv + oml * sg; Ks[e] = oml * ex * sg; Qs[e] = zq / (1.f + __expf(-zq)); Vs[e] = zi; Gs[e] = zg / (1.f + __expf(-zg));
    }
    __syncthreads();
    const int dg = tid >> 5, vq = tid & 31;
    const size_t soff = ((size_t)unit * 128 + dg * 8) * 128 + vq * 4;
    f32x4 S[8];
#pragma unroll
    for (int i = 0; i < 8; ++i) S[i] = *(const f32x4*)(P.state + soff + i * 128);
#pragma unroll 1
    for (int t = 0; t < 8; ++t) {
        const f32x4 v = *(const LAS f32x4*)(Vs + t * 128 + vq * 4); f32x4 op = (f32x4){0.f, 0.f, 0.f, 0.f};
#pragma unroll
        for (int i = 0; i < 8; ++i) { const int d = dg * 8 + i; const float f = Fs[t * 128 + d], k = Ks[t * 128 + d], q = Qs[t * 128 + d];
            S[i] = S[i] * f + v * k; op += S[i] * q; }
#pragma unroll
        for (int j = 0; j < 4; ++j) op[j] += __shfl_xor(op[j], 32);
        if (hi == 0) *(LAS f32x4*)(OP + (t * 8 + wid) * 128 + vq * 4) = op;
    }
    float* so = P.out + O_SS + soff;
#pragma unroll
    for (int i = 0; i < 8; ++i) *(f32x4*)(so + i * 128) = S[i];
    __syncthreads();
    {
        const int t = wid; float o0 = 0.f, o1 = 0.f;
#pragma unroll
        for (int w = 0; w < 8; ++w) { o0 += OP[(t * 8 + w) * 128 + lane]; o1 += OP[(t * 8 + w) * 128 + 64 + lane]; }
        const float rstd = rsqrtf(wave_sum(o0 * o0 + o1 * o1) * (1.f / 128.f) + EPS);
        bf16_t* mo = P.MIX + (size_t)(NTP + b * 8 + t) * DM + h * 128;
        mo[lane] = (bf16_t)(pk2(o0 * rstd * P.hg_norm[lane] * Gs[t * 128 + lane], 0.f) & 0xffffu);
        mo[64 + lane] = (bf16_t)(pk2(o1 * rstd * P.hg_norm[64 + lane] * Gs[t * 128 + 64 + lane], 0.f) & 0xffffu);
    }
    __syncthreads();
}

DI void scan_phase(const Ptrs& P, int G) {
    const int gt = blockIdx.x * 512 + threadIdx.x, NT = G * 512;
    for (int idx4 = gt; idx4 < 32 * 4096; idx4 += NT) {
        const int bh = idx4 >> 12, e = (idx4 & 4095) * 4, d = e >> 7;
        float* hp = P.HS + (size_t)bh * 32 * 16384 + e; const float* dp = P.DSC + bh * 32 * 128 + d;
        f32x4 S = (f32x4){0.f, 0.f, 0.f, 0.f};
#pragma unroll 1
        for (int s0 = 0; s0 < 32; s0 += 8) {
            f32x4 Hv[8]; float dv[8];
#pragma unroll
            for (int j = 0; j < 8; ++j) { Hv[j] = *(const f32x4*)(hp + (size_t)(s0 + j) * 16384); dv[j] = dp[(s0 + j) * 128]; }
#pragma unroll
            for (int j = 0; j < 8; ++j) { *(f32x4*)(hp + (size_t)(s0 + j) * 16384) = S; S = S * dv[j] + Hv[j]; }
        }
        *(f32x4*)(P.out + O_SP + (size_t)bh * 16384 + e) = S;
    }
    for (int e = gt; e < 8 * 128 * 256; e += NT) {
        const int b = e >> 15, j = (e >> 8) & 127, c = e & 255;
        const float v = bf2f(P.Z[(size_t)(b * SEQ + SEQ - 128 + j) * NIN + ZSK + c]);
        if (c < 128) P.out[O_KP + (size_t)(b * 128 + j) * 128 + c] = v; else P.out[O_VP + (size_t)(b * 128 + j) * 128 + (c - 128)] = v;
    }
}

DI void final_norm(const Ptrs& P, int G) {
    const int tid = threadIdx.x, lane = tid & 63, wave = tid >> 6;
    const int gw = blockIdx.x * 8 + wave, NGW = G * 8;
    f32x4 gv[4];
#pragma unroll
    for (int j = 0; j < 4; ++j) gv[j] = *((const f32x4*)P.ln_final + lane + 64 * j);
    for (int m = gw; m < M; m += NGW) {
        const float rstd = rsqrtf(P.rss2[m] * (1.f / DM) + EPS);
        f32x4* yr = (f32x4*)(P.out + (size_t)m * DM) + lane;
        f32x4 v[4];
#pragma unroll
        for (int j = 0; j < 4; ++j) v[j] = yr[64 * j];
#pragma unroll
        for (int j = 0; j < 4; ++j) yr[64 * j] = v[j] * rstd * gv[j];
    }
}

#define XB_TMO      128
#define XB_XCNT(j)  (256  + 64 * (j))
#define XB_XSUB(j)  (1280 + 64 * (j))
#define XB_XGEN(j)  (2304 + 64 * (j))
#define XB_TOP      3328
#define XB_TOPGEN   3392
#define XCD_BAR_WORDS 3456
#define XB_SPIN_CAP (1u << 18)
DI unsigned xb_ld(unsigned* p)              { return __hip_atomic_load(p, __ATOMIC_RELAXED, __HIP_MEMORY_SCOPE_AGENT); }
DI unsigned xb_add(unsigned* p, unsigned v) { return __hip_atomic_fetch_add(p, v, __ATOMIC_RELAXED, __HIP_MEMORY_SCOPE_AGENT); }
DI unsigned xb_xcc_id() { return (unsigned)__builtin_amdgcn_s_getreg((3 << 11) | 20) & 0xFu; }
#define XB_SPIN(cond, bar) do { unsigned _sp = 0; while (cond) { __builtin_amdgcn_s_sleep(1); \
    if ((++_sp & 255u) == 0u) { if (xb_ld(&(bar)[XB_TMO])) break; if (_sp > XB_SPIN_CAP) { atomicAdd(&(bar)[XB_TMO], 1u); break; } } } } while (0)
struct XcdBarrier { unsigned* bar; unsigned x; volatile LAS unsigned* st; };
DI XcdBarrier xcd_barrier_post(unsigned* bar, volatile LAS unsigned* st) {
    XcdBarrier b; b.bar = bar; b.x = xb_xcc_id(); b.st = st;
    if (threadIdx.x == 0) (void)xb_add(&bar[XB_XCNT(b.x)], 1u);
    return b;
}
DI void xcd_barrier_complete(unsigned* bar, unsigned x, unsigned& nloc, unsigned& nx) {
    const unsigned G = gridDim.x * gridDim.y * gridDim.z;
    unsigned sum, cnt, mine, sp = 0u;
    for (;;) {
        sum = 0u; cnt = 0u; mine = 0u;
#pragma unroll
        for (unsigned j = 0; j < 16; ++j) { const unsigned c = xb_ld(&bar[XB_XCNT(j)]); sum += c; cnt += (c > 0u) ? 1u : 0u; mine = (j == x) ? c : mine; }
        if (sum == G) break;
        __builtin_amdgcn_s_sleep(1);
        if ((++sp & 255u) == 0u) { if (xb_ld(&bar[XB_TMO])) break; if (sp > XB_SPIN_CAP) { atomicAdd(&bar[XB_TMO], 1u); break; } }
    }
    nloc = mine > 0u ? mine : 1u; nx = cnt > 0u ? cnt : 1u;
}
DI void xcd_barrier(const XcdBarrier& b) {
    asm volatile("s_waitcnt vmcnt(0)" ::: "memory");
    __syncthreads();
    if (threadIdx.x == 0) {
        unsigned* bar = b.bar;
        __builtin_amdgcn_s_waitcnt(0);
        unsigned nloc = b.st[0], nx = b.st[1];
        if (nloc == 0u) { xcd_barrier_complete(bar, b.x, nloc, nx); b.st[0] = nloc; b.st[1] = nx; }
        const unsigned old = xb_add(&bar[XB_XSUB(b.x)], 1u);
        const unsigned gen = old / nloc;
        if (old + 1u == (gen + 1u) * nloc) {
            __builtin_amdgcn_fence(__ATOMIC_RELEASE, "agent");
            asm volatile("s_waitcnt vmcnt(0)" ::: "memory");
            const unsigned og = xb_add(&bar[XB_TOP], 1u);
            const unsigned tg = og / nx;
            if (og + 1u == (tg + 1u) * nx) xb_add(&bar[XB_TOPGEN], 1u);
            else XB_SPIN(xb_ld(&bar[XB_TOPGEN]) == tg, bar);
            __builtin_amdgcn_fence(__ATOMIC_ACQUIRE, "agent");
            xb_add(&bar[XB_XGEN(b.x)], 1u);
            asm volatile("s_waitcnt vmcnt(0)" ::: "memory");
        } else {
            XB_SPIN(xb_ld(&bar[XB_XGEN(b.x)]) == gen, bar);
            __builtin_amdgcn_fence(__ATOMIC_ACQUIRE, "agent");
            asm volatile("s_waitcnt vmcnt(0)" ::: "memory");
        }
    }
    __syncthreads();
}

struct Args { const float* in[15]; float* out; unsigned char* ws; int ph_lo, ph_hi; };
constexpr int NPHASE = 9;

__global__ void __launch_bounds__(512, 2) mk_fwd(Args args) {
    extern __shared__ __attribute__((aligned(16))) unsigned char lds_raw[];
    LAS unsigned char* lds = (LAS unsigned char*)lds_raw;
    cg::grid_group grid = cg::this_grid();
    const int G = gridDim.x;
    Ptrs P;
    P.x_p = args.in[0]; P.x_s = args.in[1]; P.state = args.in[2]; P.ck = args.in[3]; P.cv = args.in[4]; P.ln_mix = args.in[5]; P.w_in = args.in[6]; P.lb_logits = args.in[7];
    P.hg_norm = args.in[8]; P.sinks = args.in[9]; P.w_out = args.in[10]; P.ln_mlp = args.in[11]; P.w_up = args.in[12]; P.w_down = args.in[13]; P.ln_final = args.in[14];
    P.out = args.out;
    unsigned char* ws = args.ws;
    P.WinT = (bf16_t*)(ws + WS_WIN); P.WoutT = (bf16_t*)(ws + WS_WOUT); P.WupT = (bf16_t*)(ws + WS_WUP); P.WdnT = (bf16_t*)(ws + WS_WDN);
    P.XN = (bf16_t*)(ws + WS_XN); P.Z = (bf16_t*)(ws + WS_Z); P.MIX = (bf16_t*)(ws + WS_MIX); P.U = (bf16_t*)(ws + WS_U);
    P.HS = (float*)(ws + WS_HS); P.DSC = (float*)(ws + WS_DSC); P.rss1 = (float*)(ws + WS_RSS1); P.rss2 = (float*)(ws + WS_RSS2);
    const int lo = args.ph_lo, hi = args.ph_hi;
    unsigned* barw = (unsigned*)(ws + WS_BAR);
    volatile LAS unsigned* misc = (volatile LAS unsigned*)(lds + LDS_MISC);
    if (threadIdx.x < 2) misc[threadIdx.x] = 0u;
    if (blockIdx.x == 0) for (int i = threadIdx.x; i < XCD_BAR_WORDS; i += 512) __hip_atomic_store(barw + i, 0u, __ATOMIC_RELAXED, __HIP_MEMORY_SCOPE_AGENT);
    XcdBarrier xbar; xbar.bar = barw; xbar.x = 0; xbar.st = misc;
#define IN(k) (lo <= (k) && (k) < hi)
#define SEAM(k) do { if (IN(k) && IN((k) + 1)) { if ((k) == 0) { grid.sync(); xbar = xcd_barrier_post(barw, misc); } else xcd_barrier(xbar); } } while (0)
    if (IN(0)) { p0_prologue(lds, P, G); if (PROBE_P0) { __syncthreads(); p0_prologue(lds, P, G); } }
    SEAM(0);
    if (PROBE_SYNC) { for (int i = 0; i < 8; ++i) grid.sync(); }
    if (IN(1)) { pg8::Gemm g{P.XN, P.WinT, M, NIN, DM}; pg8::StaticOrder S; S.init(M, NIN, G, (int)blockIdx.x); pg8::EpiZ E{P.Z, NIN};
        pg8::gemm_phase<pg8::EpiZ, pg8::StaticOrder, true>(lds, g, S, E); }
    SEAM(1);
    if (IN(2)) {
        for (int rep = 0; rep < 1 + PROBE_P2A; ++rep)
        for (int u = blockIdx.x; u < 1024; u += G) hgrn_unit<false>(lds, P, u);
        for (int rep = 0; rep < 1 + PROBE_P2A; ++rep) {
        for (int u = blockIdx.x; u < 512; u += G) swa_prompt_unit(lds, P, u);
        for (int u = blockIdx.x; u < 512; u += G) hgrn_sample_unit(lds, P, u);
        for (int u = blockIdx.x; u < 128; u += G) swa_sample_unit(lds, P, u); }
    }
    SEAM(2);
    if (IN(3)) { scan_phase(P, G); }
    SEAM(3);
    if (IN(4)) { for (int rep = 0; rep < 1 + PROBE_P2C; ++rep) for (int u = blockIdx.x; u < 1024; u += G) hgrn_unit<true>(lds, P, u); }
    SEAM(4);
    if (IN(5)) { pg8::Gemm g{P.MIX, P.WoutT, M, DM, DM}; pg8::StaticOrder S; S.init(M, DM, G, (int)blockIdx.x); pg8::EpiRes<true> E{P.x_p, P.x_s, P.out, P.XN, P.rss1};
        pg8::gemm_phase<pg8::EpiRes<true>, pg8::StaticOrder, true>(lds, g, S, E); }
    SEAM(5);
    if (IN(6)) { pg8::Gemm g{P.XN, P.WupT, M, FF, DM}; pg8::StaticOrder S; S.init(M, FF, G, (int)blockIdx.x); pg8::EpiUp E{P.U, FF, P.rss1};
        pg8::gemm_phase<pg8::EpiUp, pg8::StaticOrder, true>(lds, g, S, E); }
    SEAM(6);
    if (IN(7)) { pg8::Gemm g{P.U, P.WdnT, M, DM, FF}; pg8::StaticOrder S; S.init(M, DM, G, (int)blockIdx.x); pg8::EpiRes<false> E{nullptr, nullptr, P.out, nullptr, P.rss2};
        pg8::gemm_phase<pg8::EpiRes<false>, pg8::StaticOrder, true>(lds, g, S, E); }
    SEAM(7);
    if (IN(8)) { final_norm(P, G); }
#undef IN
#undef SEAM
}

extern "C" void kernel_launch(void* const* d_in, const int* in_sizes, int n_in, void* d_out, int out_size, void* d_ws, size_t ws_size, hipStream_t stream) {
    static int grid = 0;
    if (grid == 0) {
        if (n_in != 15 || (size_t)out_size != O_END || ws_size < WS_END) { fprintf(stderr, "kernel_launch: unexpected shapes (n_in %d out %d ws %zu)\n", n_in, out_size, ws_size); grid = -1; return; }
        int dev = 0, cus = 0, per_cu = 0;
        (void)hipGetDevice(&dev); (void)hipDeviceGetAttribute(&cus, hipDeviceAttributeMultiprocessorCount, dev);
        if (hipFuncSetAttribute((const void*)mk_fwd, hipFuncAttributeMaxDynamicSharedMemorySize, LDS_BYTES) != hipSuccess) { fprintf(stderr, "kernel_launch: hipFuncSetAttribute failed\n"); grid = -1; return; }
        if (hipOccupancyMaxActiveBlocksPerMultiprocessor(&per_cu, (const void*)mk_fwd, 512, LDS_BYTES) != hipSuccess || per_cu < 1) { fprintf(stderr, "kernel_launch: occupancy query says %d\n", per_cu); per_cu = 1; }
        (void)hipGetLastError();
        if (per_cu > 1) per_cu = 1;
        grid = cus * per_cu;
    }
    if (grid < 0) return;
    Args a{};
    for (int i = 0; i < 15; ++i) a.in[i] = (const float*)d_in[i];
    a.out = (float*)d_out; a.ws = (unsigned char*)d_ws;
#if MK_COOP
    a.ph_lo = 0; a.ph_hi = NPHASE;
    void* kargs[] = {&a};
    hipError_t e = hipLaunchCooperativeKernel((const void*)mk_fwd, dim3(grid), dim3(512), kargs, LDS_BYTES, stream);
    if (e != hipSuccess) fprintf(stderr, "cooperative launch failed: %s (grid %d)\n", hipGetErrorString(e), grid);
#else
    for (int p = 0; p < NPHASE; ++p) { a.ph_lo = p; a.ph_hi = p + 1; hipLaunchKernelGGL(mk_fwd, dim3(grid), dim3(512), LDS_BYTES, stream, a); }
#endif
}
```

```cpp
#include <hip/hip_runtime.h>
#include <hip/hip_cooperative_groups.h>
#include <cstdio>
#include <cstdint>
namespace cg = cooperative_groups;

#ifndef MK_COOP
#define MK_COOP 1
#endif
#define PROBE_P0 0
#define PROBE_P2A 0
#define PROBE_P2C 0
#define PROBE_SYNC 0

#define DI __device__ __forceinline__
#define LAS __attribute__((address_space(3)))
typedef unsigned short bf16_t;
typedef short bf16x8 __attribute__((ext_vector_type(8)));
typedef short s16x4 __attribute__((ext_vector_type(4)));
typedef float f32x4 __attribute__((ext_vector_type(4)));
typedef float f32x16 __attribute__((ext_vector_type(16)));
typedef unsigned u32x4 __attribute__((ext_vector_type(4)));
typedef unsigned u32x2 __attribute__((ext_vector_type(2)));
typedef float f32x2_t __attribute__((ext_vector_type(2)));
typedef __bf16 bf16x2_t __attribute__((ext_vector_type(2)));

DI unsigned pk2(float lo, float hi) { f32x2_t v = {lo, hi}; bf16x2_t b = __builtin_convertvector(v, bf16x2_t); return __builtin_bit_cast(unsigned, b); }
DI float bf2f(bf16_t v) { return __uint_as_float(((unsigned)v) << 16); }
DI float bflo(unsigned w) { return __uint_as_float(w << 16); }
DI float bfhi(unsigned w) { return __uint_as_float(w & 0xffff0000u); }
DI int crow(int reg, int h) { return (reg & 3) + 8 * (reg >> 2) + 4 * h; }
#define MFMA32(a, b, c) __builtin_amdgcn_mfma_f32_32x32x16_bf16((a), (b), (c), 0, 0, 0)
DI bf16x8 packs(const f32x16& x, int s) {
    u32x4 p; p.x = pk2(x[8 * s], x[8 * s + 1]); p.y = pk2(x[8 * s + 2], x[8 * s + 3]); p.z = pk2(x[8 * s + 4], x[8 * s + 5]); p.w = pk2(x[8 * s + 6], x[8 * s + 7]);
    return __builtin_bit_cast(bf16x8, p);
}
DI bf16x8 cat4(s16x4 lo, s16x4 hi) { return __builtin_shufflevector(lo, hi, 0, 1, 2, 3, 4, 5, 6, 7); }
DI float wave_sum(float v) {
#pragma unroll
    for (int o = 1; o < 64; o <<= 1) v += __shfl_xor(v, o);
    return v;
}

constexpr int DM = 1024, SEQ = 4096, NB = 8, NTP = NB * SEQ, DB = 128, DS = 8, NTS = DB * DS, M = NTP + NTS;
constexpr int NIN = 2816, FF = 4096;
constexpr int ZQ = 0, ZF = 512, ZI = 1024, ZG = 1536, ZSQ = 2048, ZSK = 2560, ZSV = 2688;
constexpr float EPS = 1e-6f;
constexpr size_t O_Y = 0, O_SP = (size_t)M * DM, O_KP = O_SP + 8 * 4 * 128 * 128, O_VP = O_KP + 8 * 128 * 128, O_SS = O_VP + 8 * 128 * 128,
                 O_KS = O_SS + (size_t)128 * 4 * 128 * 128, O_VS = O_KS + (size_t)128 * 128 * 128, O_END = O_VS + (size_t)128 * 128 * 128;
constexpr size_t MiB = 1u << 20;
constexpr size_t WS_RSS1 = 0, WS_RSS2 = 256 * 1024, WS_BAR = 512 * 1024, WS_WIN = 1 * MiB, WS_WOUT = 7 * MiB, WS_WUP = 9 * MiB, WS_WDN = 17 * MiB, WS_DSC = 25 * MiB,
                 WS_XN = 26 * MiB, WS_Z = 92 * MiB, WS_MIX = 274 * MiB, WS_HS = 340 * MiB, WS_U = 92 * MiB, WS_PART = 404 * MiB, WS_END = 468 * MiB;
static_assert(WS_XN + (size_t)M * DM * 2 <= WS_Z && WS_Z + (size_t)M * NIN * 2 <= WS_MIX && WS_MIX + (size_t)M * DM * 2 <= WS_HS && WS_U + (size_t)M * FF * 2 <= WS_END, "ws map");
constexpr int LDS_BYTES = 147456, LDS_MISC = 147456 - 64;

namespace pg8 {
constexpr int BM = 256, BK = 64, HALF = 128, HTB = HALF * BK * 2, STAGE_BYTES = 8 * HTB, NXCD = 8, WGM = 8;
DI int lds_byte(int r, int c) { const int st = (r >> 4) * 2 + (c >> 5), rr = r & 15, cc = c & 31, ob = rr * 64 + cc * 2; return st * 1024 + (ob ^ (((ob >> 9) & 1) << 5)); }
DI void stage_rc(int b, int& R, int& C) { const int st = b / 1024, sb = b % 1024, swz = sb ^ (((sb >> 9) & 1) << 5); R = (st >> 1) * 16 + swz / 64; C = (st & 1) * 32 + (swz % 64) / 2; }
DI int perm32(int rho) { const int n = rho >> 4, i = rho & 15; return 8 * (i >> 2) + 4 * n + (i & 3); }
struct Unit { int pm, pn, kt0; };
struct Gemm { const bf16_t* A; const bf16_t* Bt; int K, nt; };
struct StaticOrder {
    int nM, nN, nwg, G, c;
    DI void init(int M_, int N_, int G_, int c_) { nM = M_ / BM; nN = N_ / BM; nwg = nM * nN; G = G_; c = c_; }
    DI bool next(int i, Unit& u) const {
        const long L = (long)i * G + c; if (L >= nwg) return false;
        int wgid = (int)L; { const int q = nwg / NXCD, r = nwg % NXCD, xcd = wgid % NXCD, off = wgid / NXCD; wgid = (xcd < r ? xcd * (q + 1) : r * (q + 1) + (xcd - r) * q) + off; }
        const int nig = WGM * nN, gid = wgid / nig, fm = gid * WGM, gsz = (nM - fm) < WGM ? (nM - fm) : WGM;
        u.pm = fm + ((wgid % nig) % gsz); u.pn = (wgid % nig) / gsz; u.kt0 = 0; return true;
    }
};
struct RectOrder {
    int pm0, nN, nslice, nt, total, G, c;
    DI void init(int pm0_, int nPm, int nN_, int nslice_, int nt_, int G_, int c_) { pm0 = pm0_; nN = nN_; nslice = nslice_; nt = nt_; total = nPm * nN_ * nslice_; G = G_; c = c_; }
    DI bool next(int i, Unit& u) const {
        const long L = (long)i * G + c; if (L >= total) return false;
        const int sl = (int)L % nslice, t = (int)L / nslice; u.pn = t % nN; u.pm = pm0 + t / nN; u.kt0 = sl * nt; return true;
    }
};
struct EpiZ {
    static constexpr bool PERM = true;
    bf16_t* O; int ldc;
    DI void operator()(const f32x4 (&acc)[2][2][4][2], const Unit& u, int wr, int wc, int fr, int fq) const {
        const int row0 = u.pm * BM + wr * 64 + fr, col0 = u.pn * BM + wc * 32 + 8 * fq;
#pragma unroll
        for (int ai = 0; ai < 2; ++ai)
#pragma unroll
            for (int m = 0; m < 4; ++m) { bf16_t* rowp = O + (size_t)(row0 + ai * HALF + m * 16) * ldc + col0;
#pragma unroll
                for (int bj = 0; bj < 2; ++bj) { const f32x4 v0 = acc[ai][bj][m][0], v1 = acc[ai][bj][m][1];
                    u32x4 w; w.x = pk2(v0[0], v0[1]); w.y = pk2(v0[2], v0[3]); w.z = pk2(v1[0], v1[1]); w.w = pk2(v1[2], v1[3]);
                    *(u32x4*)(rowp + bj * HALF) = w; } }
    }
};
struct EpiUp {
    static constexpr bool PERM = true;
    bf16_t* O; int ldc; const float* rowss;
    DI void operator()(const f32x4 (&acc)[2][2][4][2], const Unit& u, int wr, int wc, int fr, int fq) const {
        const int row0 = u.pm * BM + wr * 64 + fr, col0 = u.pn * BM + wc * 32 + 8 * fq;
#pragma unroll
        for (int ai = 0; ai < 2; ++ai)
#pragma unroll
            for (int m = 0; m < 4; ++m) { const int r = row0 + ai * HALF + m * 16; bf16_t* rowp = O + (size_t)r * ldc + col0;
                const float rs = rsqrtf(rowss[r] * (1.0f / DM) + EPS);
#pragma unroll
                for (int bj = 0; bj < 2; ++bj) { f32x4 v0 = acc[ai][bj][m][0] * rs, v1 = acc[ai][bj][m][1] * rs;
#pragma unroll
                    for (int j = 0; j < 4; ++j) { const float a = fmaxf(v0[j], 0.f), b = fmaxf(v1[j], 0.f); v0[j] = a * a; v1[j] = b * b; }
                    u32x4 w; w.x = pk2(v0[0], v0[1]); w.y = pk2(v0[2], v0[3]); w.z = pk2(v1[0], v1[1]); w.w = pk2(v1[2], v1[3]);
                    *(u32x4*)(rowp + bj * HALF) = w; } }
    }
};
struct EpiRes1 {
    static constexpr bool PERM = false;
    const float* xp; const float* xs; float* out; bf16_t* hb; float* rowss;
    DI void operator()(const f32x4 (&acc)[2][2][4][2], const Unit& u, int wr, int wc, int fr, int fq) const {
        const int col0 = u.pn * BM + wc * 32 + 4 * fq;
#pragma unroll
        for (int ai = 0; ai < 2; ++ai)
#pragma unroll
            for (int m = 0; m < 4; ++m) { const int r = u.pm * BM + ai * HALF + wr * 64 + m * 16 + fr;
                const float* base = r < NTP ? xp + (size_t)r * DM : xs + (size_t)(r - NTP) * DM;
                float* orow = out + (size_t)r * DM; float ss = 0.f;
#pragma unroll
                for (int bj = 0; bj < 2; ++bj)
#pragma unroll
                    for (int n = 0; n < 2; ++n) { const int c = col0 + bj * HALF + n * 16; const f32x4 o = *(const f32x4*)(base + c) + acc[ai][bj][m][n];
                        ss += (o[0] * o[0] + o[1] * o[1]) + (o[2] * o[2] + o[3] * o[3]); *(f32x4*)(orow + c) = o;
                        u32x2 w; w.x = pk2(o[0], o[1]); w.y = pk2(o[2], o[3]); *(u32x2*)(hb + (size_t)r * DM + c) = w; }
                ss += __shfl_xor(ss, 16); ss += __shfl_xor(ss, 32);
                if (fq == 0) unsafeAtomicAdd(rowss + r, ss); }
    }
};
template <bool PARTIAL> struct EpiDown {
    static constexpr bool PERM = false;
    float* out; float* part;
    DI void operator()(const f32x4 (&acc)[2][2][4][2], const Unit& u, int wr, int wc, int fr, int fq) const {
        const int col0 = u.pn * BM + wc * 32 + 4 * fq;
#pragma unroll
        for (int ai = 0; ai < 2; ++ai)
#pragma unroll
            for (int m = 0; m < 4; ++m) { const int r = u.pm * BM + ai * HALF + wr * 64 + m * 16 + fr;
                float* orow = PARTIAL ? part + ((size_t)(u.kt0 >> 2) * NTS + (size_t)(r - NTP)) * DM : out + (size_t)r * DM;
#pragma unroll
                for (int bj = 0; bj < 2; ++bj)
#pragma unroll
                    for (int n = 0; n < 2; ++n) { const int c = col0 + bj * HALF + n * 16;
                        if (PARTIAL) *(f32x4*)(orow + c) = acc[ai][bj][m][n];
                        else *(f32x4*)(orow + c) = *(const f32x4*)(orow + c) + acc[ai][bj][m][n]; } }
    }
};

template <class Epi, class Sched, bool ALIGN_EPI = true, bool OPAQUE_NT = false>
DI void gemm_phase(LAS unsigned char* lds, const Gemm g, const Sched& S, const Epi& E) {
    const int tid = threadIdx.x, wid = __builtin_amdgcn_readfirstlane(tid >> 6), lane = tid & 63, wr = wid >> 2, wc = wid & 3, fr = lane & 15, fq = lane >> 4;
    const int K = g.K; int nt = g.nt; if (OPAQUE_NT) asm volatile("" : "+s"(nt));
    unsigned voffA[2], voffB[2];
#pragma unroll
    for (int i = 0; i < 2; ++i) { int R, C; stage_rc(tid * 16 + i * 8192, R, C); const int Rb = Epi::PERM ? ((R & ~31) + perm32(R & 31)) : R;
        voffA[i] = (unsigned)(R * K + C) * 2u; voffB[i] = (unsigned)(Rb * K + C) * 2u; }
    const size_t kstep = (size_t)(BK * 2);
    const size_t hstep = (size_t)HALF * K * 2;
    const size_t tstep = 2 * hstep;
    const unsigned ldsw = (unsigned)wid * 1024u;
    const int aoff = lds_byte(wr * 64 + fr, fq * 8), boff = lds_byte(wc * 32 + fr, fq * 8);
#define PG8_SA(b, h) (((b) * 2 + (h)) * HTB)
#define PG8_SB(b, h) ((4 + (b) * 2 + (h)) * HTB)
#define PG8_STAGE(bufoff, gbase, voff) do { _Pragma("unroll") for (int _i = 0; _i < 2; ++_i) \
        __builtin_amdgcn_global_load_lds((const unsigned*)((const char*)(gbase) + (voff)[_i]), (LAS unsigned*)(lds + (bufoff) + ldsw + _i * 8192), 16, 0, 0); } while (0)
#define PG8_LDA(dst, b, h) do { _Pragma("unroll") for (int m = 0; m < 4; ++m) _Pragma("unroll") for (int k = 0; k < 2; ++k) dst[m][k] = *(const LAS bf16x8*)(lds + PG8_SA(b, h) + aoff + m * 2048 + k * 1024); } while (0)
#define PG8_LDB(dst, b, h) do { _Pragma("unroll") for (int n = 0; n < 2; ++n) _Pragma("unroll") for (int k = 0; k < 2; ++k) dst[n][k] = *(const LAS bf16x8*)(lds + PG8_SB(b, h) + boff + n * 2048 + k * 1024); } while (0)
#define PG8_MMA(ai, bj, At, Bt) do { __builtin_amdgcn_s_setprio(1); _Pragma("unroll") for (int m = 0; m < 4; ++m) _Pragma("unroll") for (int n = 0; n < 2; ++n) _Pragma("unroll") for (int k = 0; k < 2; ++k) \
        acc[ai][bj][m][n] = __builtin_amdgcn_mfma_f32_16x16x32_bf16(Bt[n][k], At[m][k], acc[ai][bj][m][n], 0, 0, 0); __builtin_amdgcn_s_setprio(0); } while (0)
#define PG8_WAIT_V(n) asm volatile("s_waitcnt vmcnt(" #n ")" ::: "memory")
#define PG8_WAIT_L(n) asm volatile("s_waitcnt lgkmcnt(" #n ")" ::: "memory")
#define PG8_BAR __builtin_amdgcn_s_barrier()
#define PG8_SCHED __builtin_amdgcn_sched_barrier(0)
    Unit cur, nxt; int ui = 0;
    if (!S.next(0, cur)) return;
    f32x4 acc[2][2][4][2];
#pragma unroll
    for (int a = 0; a < 2; ++a)
#pragma unroll
        for (int b = 0; b < 2; ++b)
#pragma unroll
            for (int m = 0; m < 4; ++m)
#pragma unroll
                for (int n = 0; n < 2; ++n) acc[a][b][m][n] = (f32x4){0.f, 0.f, 0.f, 0.f};
    bf16x8 At[4][2], B0[2][2], B1[2][2];
    const char* cA = (const char*)g.A + (size_t)cur.pm * tstep + (size_t)cur.kt0 * kstep; const char* cB = (const char*)g.Bt + (size_t)cur.pn * tstep + (size_t)cur.kt0 * kstep;
    PG8_STAGE(PG8_SB(0, 0), cB, voffB); PG8_STAGE(PG8_SB(0, 1), cB + hstep, voffB); PG8_STAGE(PG8_SA(0, 0), cA, voffA); PG8_STAGE(PG8_SA(0, 1), cA + hstep, voffA);
    if (wr == 1) PG8_BAR;
    PG8_WAIT_V(2); PG8_BAR;
    PG8_STAGE(PG8_SB(1, 0), cB + kstep, voffB); PG8_STAGE(PG8_SA(1, 0), cA + kstep, voffA); PG8_STAGE(PG8_SB(1, 1), cB + hstep + kstep, voffB);
    PG8_WAIT_V(6); PG8_BAR;
    for (;;) {
        const bool has_next = S.next(ui + 1, nxt);
        const char* nA = has_next ? (const char*)g.A + (size_t)nxt.pm * tstep + (size_t)nxt.kt0 * kstep : cA; const char* nB = has_next ? (const char*)g.Bt + (size_t)nxt.pn * tstep + (size_t)nxt.kt0 * kstep : cB;
        for (int t = 0; t < nt; t += 2) {
            const bool last = (t == nt - 2);
            const char* a1 = cA + (size_t)(t + 1) * kstep;
            const char* a2 = last ? nA : cA + (size_t)(t + 2) * kstep; const char* b2 = last ? nB : cB + (size_t)(t + 2) * kstep;
            const char* a3 = a2 + kstep; const char* b3 = b2 + kstep;
            PG8_LDB(B0, 0, 0); PG8_LDB(B1, 0, 1); PG8_SCHED; PG8_LDA(At, 0, 0); PG8_STAGE(PG8_SA(1, 1), a1 + hstep, voffA);
            PG8_WAIT_V(8); PG8_WAIT_L(0); PG8_BAR; PG8_MMA(0, 0, At, B0); PG8_MMA(0, 1, At, B1); PG8_BAR; PG8_SCHED;
            PG8_LDA(At, 0, 1); PG8_STAGE(PG8_SB(0, 0), b2, voffB); PG8_STAGE(PG8_SB(0, 1), b2 + hstep, voffB); PG8_STAGE(PG8_SA(0, 0), a2, voffA);
            PG8_WAIT_V(8); PG8_WAIT_L(0); PG8_BAR; PG8_MMA(1, 0, At, B0); PG8_MMA(1, 1, At, B1); PG8_BAR; PG8_SCHED;
            PG8_LDB(B0, 1, 0); PG8_LDB(B1, 1, 1); PG8_SCHED; PG8_LDA(At, 1, 0); PG8_STAGE(PG8_SA(0, 1), a2 + hstep, voffA);
            PG8_WAIT_V(8); PG8_WAIT_L(0); PG8_BAR; PG8_MMA(0, 0, At, B0); PG8_MMA(0, 1, At, B1); PG8_BAR; PG8_SCHED;
            PG8_LDA(At, 1, 1); PG8_STAGE(PG8_SB(1, 0), b3, voffB); PG8_STAGE(PG8_SB(1, 1), b3 + hstep, voffB); PG8_STAGE(PG8_SA(1, 0), a3, voffA);
            PG8_WAIT_V(8); PG8_WAIT_L(0); PG8_BAR; PG8_MMA(1, 0, At, B0); PG8_MMA(1, 1, At, B1); PG8_BAR; PG8_SCHED;
        }
        if constexpr (ALIGN_EPI) { if (wr == 0) PG8_BAR; }
        E(acc, cur, wr, wc, fr, fq);
        if (!has_next) break;
#pragma unroll
        for (int a = 0; a < 2; ++a)
#pragma unroll
            for (int b = 0; b < 2; ++b)
#pragma unroll
                for (int m = 0; m < 4; ++m)
#pragma unroll
                    for (int n = 0; n < 2; ++n) acc[a][b][m][n] = (f32x4){0.f, 0.f, 0.f, 0.f};
        cur = nxt; cA = nA; cB = nB; ++ui;
        if constexpr (ALIGN_EPI) { if (wr == 1) PG8_BAR; }
    }
    PG8_WAIT_V(0);
    if constexpr (!ALIGN_EPI) { if (wr == 0) PG8_BAR; }
    PG8_BAR;
#undef PG8_SA
#undef PG8_SB
#undef PG8_STAGE
#undef PG8_LDA
#undef PG8_LDB
#undef PG8_MMA
#undef PG8_WAIT_V
#undef PG8_WAIT_L
#undef PG8_BAR
#undef PG8_SCHED
}
}

struct Ptrs {
    const float *x_p, *x_s, *state, *ck, *cv, *ln_mix, *w_in, *lb_logits, *hg_norm, *sinks, *w_out, *ln_mlp, *w_up, *w_down, *ln_final;
    float* out;
    bf16_t *WinT, *WoutT, *WupT, *WdnT, *XN, *Z, *MIX, *U;
    float *HS, *DSC, *rss1, *rss2, *PART;
};

DI void p0_transpose_item(const float* W, int K, int N, bf16_t* WT, const float* kscale, LAS float* scr, int item, int lane) {
    const int nblk = N / 32, kb = item / nblk, nb = item % nblk, k0 = 64 * kb, n0 = 32 * nb;
#pragma unroll 8
    for (int i = 0; i < 32; ++i) { const int kk = 2 * i + (lane >> 5); float v = W[(size_t)(k0 + kk) * N + n0 + (lane & 31)]; if (kscale) v *= kscale[k0 + kk]; scr[kk * 33 + (lane & 31)] = v; }
    asm volatile("s_waitcnt lgkmcnt(0)" ::: "memory");
    const int c = lane & 7;
#pragma unroll
    for (int j = 0; j < 4; ++j) { const int n = (lane >> 3) + 8 * j; const LAS float* s = scr + (8 * c) * 33 + n;
        u32x4 o; o.x = pk2(s[0 * 33], s[1 * 33]); o.y = pk2(s[2 * 33], s[3 * 33]); o.z = pk2(s[4 * 33], s[5 * 33]); o.w = pk2(s[6 * 33], s[7 * 33]);
        *(u32x4*)(WT + (size_t)(n0 + n) * K + k0 + 8 * c) = o; }
    asm volatile("s_waitcnt lgkmcnt(0)" ::: "memory");
}
DI void p0_prologue(LAS unsigned char* lds, const Ptrs& P, int G) {
    const int tid = threadIdx.x, lane = tid & 63, wave = __builtin_amdgcn_readfirstlane(tid >> 6);
    LAS float* scr = (LAS float*)(lds + wave * 16384);
    const int gw = blockIdx.x * 8 + wave, NGW = G * 8;
    constexpr int I_IN = (DM / 64) * (NIN / 32), I_O = (DM / 64) * (DM / 32), I_UP = (DM / 64) * (FF / 32), I_DN = (FF / 64) * (DM / 32);
    constexpr int NITEMS = I_IN + I_O + I_UP + I_DN;
    for (int it = gw; it < NITEMS; it += NGW) {
        int r = it;
        if (r < I_IN) { p0_transpose_item(P.w_in, DM, NIN, P.WinT, nullptr, scr, r, lane); continue; } r -= I_IN;
        if (r < I_O) { p0_transpose_item(P.w_out, DM, DM, P.WoutT, nullptr, scr, r, lane); continue; } r -= I_O;
        if (r < I_UP) { p0_transpose_item(P.w_up, DM, FF, P.WupT, P.ln_mlp, scr, r, lane); continue; } r -= I_UP;
        p0_transpose_item(P.w_down, FF, DM, P.WdnT, nullptr, scr, r, lane);
    }
    f32x4 gv[4];
#pragma unroll
    for (int j = 0; j < 4; ++j) gv[j] = *((const f32x4*)P.ln_mix + lane + 64 * j);
    for (int m = gw; m < M; m += NGW) {
        const float* xrow = m < NTP ? P.x_p + (size_t)m * DM : P.x_s + (size_t)(m - NTP) * DM;
        const f32x4* xr = (const f32x4*)xrow + lane;
        f32x4 v[4]; float s = 0.f;
#pragma unroll
        for (int j = 0; j < 4; ++j) { v[j] = xr[64 * j]; s += (v[j].x * v[j].x + v[j].y * v[j].y) + (v[j].z * v[j].z + v[j].w * v[j].w); }
        const float rstd = rsqrtf(wave_sum(s) * (1.f / DM) + EPS);
        unsigned long long* o8 = (unsigned long long*)(P.XN + (size_t)m * DM) + lane;
#pragma unroll
        for (int j = 0; j < 4; ++j) { const f32x4 w = v[j] * rstd * gv[j]; o8[64 * j] = (unsigned long long)pk2(w.x, w.y) | ((unsigned long long)pk2(w.z, w.w) << 32); }
    }
    for (int i = blockIdx.x * 512 + tid; i < M; i += G * 512) P.rss1[i] = 0.f;
}

constexpr int HSTR = 136, HROWB = HSTR * 2;
constexpr int OFF_QT = 0, OFF_KT = 128 * HROWB, OFF_KET = 2 * 128 * HROWB, OFF_VT = 3 * 128 * HROWB, OFF_DEC = 4 * 128 * HROWB, OFF_SS = OFF_DEC + 2048;
static_assert(OFF_SS + 512 <= LDS_BYTES, "hgrn lds");
template <bool FULL>
DI void hgrn_unit(LAS unsigned char* lds, const Ptrs& P, int unit) {
    const int tid = threadIdx.x, lane = tid & 63, wid = __builtin_amdgcn_readfirstlane(tid >> 6), r32 = lane & 31, hi = lane >> 5;
    const int bh = unit >> 5, sc = unit & 31, b = bh >> 2, h = bh & 3;
    const size_t row0 = (size_t)b * SEQ + sc * 128;
    LAS float* DEC = (LAS float*)(lds + OFF_DEC);
    LAS float* SSb = (LAS float*)(lds + OFF_SS);
    {
        const int c = tid >> 7, d = tid & 127;
        const float l0 = P.lb_logits[h * 128 + d], l1 = P.lb_logits[512 + h * 128 + d];
        const float lbv = 1.f / (1.f + __expf(l1 - l0)), oml = 1.f - lbv;
        const bf16_t* zrow = P.Z + (row0 + c * 32) * NIN + h * 128 + d;
        float bcum[32], kk[32]; float cum = 0.f;
#pragma unroll
        for (int t = 0; t < 32; ++t) {
            float zf = bf2f(zrow[(size_t)t * NIN + ZF]); zf = fminf(fmaxf(zf, -30.f), 30.f);
            const float e = __expf(-zf), sg = 1.f / (1.f + e);
            const float f = lbv + oml * sg, k = oml * e * sg;
            cum += __logf(f); bcum[t] = cum; kk[t] = k;
            if (FULL) {
                const float zq = bf2f(zrow[(size_t)t * NIN + ZQ]);
                const float q = zq / (1.f + __expf(-zq));
                *(LAS bf16_t*)(lds + OFF_QT + (c * 32 + t) * HROWB + d * 2) = (bf16_t)(pk2(q * __expf(cum), 0.f) & 0xffffu);
                *(LAS bf16_t*)(lds + OFF_KT + (c * 32 + t) * HROWB + d * 2) = (bf16_t)(pk2(k * __expf(-cum), 0.f) & 0xffffu);
            }
        }
        DEC[c * 128 + d] = __expf(cum);
#pragma unroll
        for (int t8 = 0; t8 < 4; ++t8) {
            u32x4 w;
            w.x = pk2(kk[8 * t8 + 0] * __expf(cum - bcum[8 * t8 + 0]), kk[8 * t8 + 1] * __expf(cum - bcum[8 * t8 + 1]));
            w.y = pk2(kk[8 * t8 + 2] * __expf(cum - bcum[8 * t8 + 2]), kk[8 * t8 + 3] * __expf(cum - bcum[8 * t8 + 3]));
            w.z = pk2(kk[8 * t8 + 4] * __expf(cum - bcum[8 * t8 + 4]), kk[8 * t8 + 5] * __expf(cum - bcum[8 * t8 + 5]));
            w.w = pk2(kk[8 * t8 + 6] * __expf(cum - bcum[8 * t8 + 6]), kk[8 * t8 + 7] * __expf(cum - bcum[8 * t8 + 7]));
            *(LAS u32x4*)(lds + OFF_KET + d * HROWB + (c * 32 + 8 * t8) * 2) = w;
        }
#pragma unroll
        for (int t8 = 0; t8 < 4; ++t8) {
            unsigned v[8];
#pragma unroll
            for (int j = 0; j < 8; ++j) v[j] = zrow[(size_t)(8 * t8 + j) * NIN + ZI];
            u32x4 w; w.x = v[0] | (v[1] << 16); w.y = v[2] | (v[3] << 16); w.z = v[4] | (v[5] << 16); w.w = v[6] | (v[7] << 16);
            *(LAS u32x4*)(lds + OFF_VT + d * HROWB + (c * 32 + 8 * t8) * 2) = w;
        }
    }
    __syncthreads();
    const bool act = wid < 4; const int vb = wid & 3;
    f32x16 S[4];
    float* HSu = P.HS + (size_t)unit * 16384;
#pragma unroll
    for (int i = 0; i < 4; ++i)
#pragma unroll
        for (int r = 0; r < 16; ++r) S[i][r] = (FULL && act) ? HSu[(32 * i + crow(r, hi)) * 128 + vb * 32 + r32] : 0.f;
#pragma unroll 1
    for (int c = 0; c < 4; ++c) {
        f32x16 o0;
#pragma unroll
        for (int r = 0; r < 16; ++r) o0[r] = 0.f;
        if (act) {
            if (FULL) {
                f32x16 at;
#pragma unroll
                for (int r = 0; r < 16; ++r) at[r] = 0.f;
#pragma unroll
                for (int ks = 0; ks < 8; ++ks) {
                    const bf16x8 a = *(const LAS bf16x8*)(lds + OFF_KT + (c * 32 + r32) * HROWB + (ks * 16 + 8 * hi) * 2);
                    const bf16x8 bq = *(const LAS bf16x8*)(lds + OFF_QT + (c * 32 + r32) * HROWB + (ks * 16 + 8 * hi) * 2);
                    at = MFMA32(a, bq, at);
                }
#pragma unroll
                for (int r = 0; r < 16; ++r) if (crow(r, hi) > r32) at[r] = 0.f;
#pragma unroll
                for (int s2 = 0; s2 < 2; ++s2) {
                    const bf16x8 pa = packs(at, s2);
                    const LAS unsigned char* vp = lds + OFF_VT + (vb * 32 + r32) * HROWB + (c * 32 + 16 * s2 + 4 * hi) * 2;
                    const bf16x8 av = cat4(*(const LAS s16x4*)vp, *(const LAS s16x4*)(vp + 16));
                    o0 = MFMA32(av, pa, o0);
                }
#pragma unroll
                for (int i = 0; i < 4; ++i)
#pragma unroll
                    for (int s2 = 0; s2 < 2; ++s2) {
                        const bf16x8 sa = packs(S[i], s2);
                        const LAS unsigned char* qp = lds + OFF_QT + (c * 32 + r32) * HROWB + (32 * i + 16 * s2 + 4 * hi) * 2;
                        const bf16x8 bq = cat4(*(const LAS s16x4*)qp, *(const LAS s16x4*)(qp + 16));
                        o0 = MFMA32(sa, bq, o0);
                    }
            }
#pragma unroll
            for (int i = 0; i < 4; ++i) {
#pragma unroll
                for (int g4 = 0; g4 < 4; ++g4) { const f32x4 dv = *(const LAS f32x4*)(DEC + c * 128 + 32 * i + 8 * g4 + 4 * hi);
#pragma unroll
                    for (int j = 0; j < 4; ++j) S[i][4 * g4 + j] *= dv[j]; }
#pragma unroll
                for (int k2 = 0; k2 < 2; ++k2) {
                    const bf16x8 a = *(const LAS bf16x8*)(lds + OFF_KET + (32 * i + r32) * HROWB + (c * 32 + 16 * k2 + 8 * hi) * 2);
                    const bf16x8 bv = *(const LAS bf16x8*)(lds + OFF_VT + (vb * 32 + r32) * HROWB + (c * 32 + 16 * k2 + 8 * hi) * 2);
                    S[i] = MFMA32(a, bv, S[i]);
                }
            }
        }
        if (FULL) {
            if (act) { float ss = 0.f;
#pragma unroll
                for (int r = 0; r < 16; ++r) ss += o0[r] * o0[r];
                ss += __shfl_xor(ss, 32);
                if (hi == 0) SSb[wid * 32 + r32] = ss; }
            __syncthreads();
            if (act) {
                const float tot = (SSb[r32] + SSb[32 + r32]) + (SSb[64 + r32] + SSb[96 + r32]);
                const float rstd = rsqrtf(tot * (1.f / 128.f) + EPS);
                const size_t row = row0 + c * 32 + r32;
#pragma unroll
                for (int g4 = 0; g4 < 4; ++g4) {
                    const int v0 = vb * 32 + 8 * g4 + 4 * hi;
                    const u32x2 zg = *(const u32x2*)(P.Z + row * NIN + ZG + h * 128 + v0);
                    const f32x4 gn = *(const f32x4*)(P.hg_norm + v0);
                    float gz[4] = {bflo(zg.x), bfhi(zg.x), bflo(zg.y), bfhi(zg.y)}; float ov[4];
#pragma unroll
                    for (int j = 0; j < 4; ++j) ov[j] = o0[4 * g4 + j] * rstd * gn[j] * (gz[j] / (1.f + __expf(-gz[j])));
                    u32x2 w; w.x = pk2(ov[0], ov[1]); w.y = pk2(ov[2], ov[3]);
                    *(u32x2*)(P.MIX + row * DM + h * 128 + v0) = w;
                }
            }
            __syncthreads();
        }
    }
    if (!FULL) {
        if (act) {
#pragma unroll
            for (int i = 0; i < 4; ++i)
#pragma unroll
                for (int r = 0; r < 16; ++r) HSu[(32 * i + crow(r, hi)) * 128 + vb * 32 + r32] = S[i][r];
        }
        if (tid < 128) P.DSC[unit * 128 + tid] = (DEC[tid] * DEC[128 + tid]) * (DEC[256 + tid] * DEC[384 + tid]);
    }
    __syncthreads();
}

template <class MaskF>
DI void swa_tile(const LAS unsigned char* KSb, int kstrideB, const LAS unsigned char* VTb, int vstrideB, const bf16_t* qrow, float sink, MaskF valid, bf16_t* orow, int r32, int hi) {
    bf16x8 qf[4];
#pragma unroll
    for (int ks = 0; ks < 4; ++ks) qf[ks] = *(const bf16x8*)(qrow + 16 * ks + 8 * hi);
    f32x16 st[5];
#pragma unroll
    for (int kt = 0; kt < 5; ++kt) {
#pragma unroll
        for (int r = 0; r < 16; ++r) st[kt][r] = 0.f;
#pragma unroll
        for (int ks = 0; ks < 4; ++ks) { const bf16x8 a = *(const LAS bf16x8*)(KSb + (32 * kt + r32) * kstrideB + (16 * ks + 8 * hi) * 2); st[kt] = MFMA32(a, qf[ks], st[kt]); }
    }
    float m = sink;
#pragma unroll
    for (int kt = 0; kt < 5; ++kt)
#pragma unroll
        for (int r = 0; r < 16; ++r) { const int jr = 32 * kt + crow(r, hi); const float s = valid(jr) ? st[kt][r] * 0.125f : -INFINITY; st[kt][r] = s; m = fmaxf(m, s); }
    m = fmaxf(m, __shfl_xor(m, 32));
    float den = 0.f;
#pragma unroll
    for (int kt = 0; kt < 5; ++kt)
#pragma unroll
        for (int r = 0; r < 16; ++r) { const float p = __expf(st[kt][r] - m); st[kt][r] = p; den += p; }
    den += __shfl_xor(den, 32);
    den += __expf(sink - m);
    f32x16 o[2];
#pragma unroll
    for (int r = 0; r < 16; ++r) { o[0][r] = 0.f; o[1][r] = 0.f; }
#pragma unroll
    for (int kt = 0; kt < 5; ++kt)
#pragma unroll
        for (int s2 = 0; s2 < 2; ++s2) {
            const bf16x8 pb = packs(st[kt], s2);
#pragma unroll
            for (int dt = 0; dt < 2; ++dt) {
                const LAS unsigned char* vp = VTb + (32 * dt + r32) * vstrideB + (32 * kt + 16 * s2 + 4 * hi) * 2;
                const bf16x8 av = cat4(*(const LAS s16x4*)vp, *(const LAS s16x4*)(vp + 16));
                o[dt] = MFMA32(av, pb, o[dt]);
            }
        }
    const float inv = 1.f / den;
#pragma unroll
    for (int dt = 0; dt < 2; ++dt)
#pragma unroll
        for (int g4 = 0; g4 < 4; ++g4) { const int d0 = 32 * dt + 8 * g4 + 4 * hi;
            u32x2 w; w.x = pk2(o[dt][4 * g4] * inv, o[dt][4 * g4 + 1] * inv); w.y = pk2(o[dt][4 * g4 + 2] * inv, o[dt][4 * g4 + 3] * inv);
            *(u32x2*)(orow + d0) = w; }
}

constexpr int PK_STRB = 144, PV_STRB = 528, P_OFF_V = 256 * PK_STRB;
DI void swa_prompt_unit(LAS unsigned char* lds, const Ptrs& P, int unit) {
    const int tid = threadIdx.x, lane = tid & 63, wid = __builtin_amdgcn_readfirstlane(tid >> 6), r32 = lane & 31, hi = lane >> 5;
    const int kvh = unit & 1, n = (unit >> 1) & 31, b = unit >> 6;
    const long rowk0 = (long)b * SEQ + (long)(n - 1) * 128;
#pragma unroll
    for (int i = 0; i < 4; ++i) {
        const int q = tid + 512 * i, j = q >> 3, part = q & 7;
        u32x4 kv = (u32x4){0u, 0u, 0u, 0u}, vv = (u32x4){0u, 0u, 0u, 0u};
        if (n > 0 || j >= 128) { const bf16_t* zr = P.Z + (size_t)(rowk0 + j) * NIN + kvh * 64 + part * 8; kv = *(const u32x4*)(zr + ZSK); vv = *(const u32x4*)(zr + ZSV); }
        *(LAS u32x4*)(lds + j * PK_STRB + part * 16) = kv;
        LAS bf16_t* vt = (LAS bf16_t*)(lds + P_OFF_V + (part * 8) * PV_STRB + j * 2);
        const unsigned vw[4] = {vv.x, vv.y, vv.z, vv.w};
#pragma unroll
        for (int e = 0; e < 4; ++e) { vt[(2 * e) * (PV_STRB / 2)] = (bf16_t)(vw[e] & 0xffffu); vt[(2 * e + 1) * (PV_STRB / 2)] = (bf16_t)(vw[e] >> 16); }
    }
    __syncthreads();
    const int g = wid >> 1, half = wid & 1, qh = kvh * 4 + g;
    const float sink = P.sinks[qh];
    const int jmin = n == 0 ? 128 : 0;
#pragma unroll 1
    for (int sub = 0; sub < 2; ++sub) {
        const int i0 = 64 * half + 32 * sub;
        const size_t row = (size_t)b * SEQ + n * 128 + i0 + r32;
        auto valid = [=](int jr) { return (jr > r32) && (jr <= r32 + 128) && (i0 + jr >= jmin); };
        swa_tile(lds + i0 * PK_STRB, PK_STRB, lds + P_OFF_V + i0 * 2, PV_STRB, P.Z + row * NIN + ZSQ + qh * 64, sink, valid, P.MIX + row * DM + 512 + qh * 64, r32, hi);
    }
    __syncthreads();
}

constexpr int SK_STRB = 144, SV_STRB = 336, S_OFF_V = 2 * 160 * SK_STRB;
static_assert(S_OFF_V + 2 * 64 * SV_STRB <= LDS_BYTES, "swa sample lds");
DI void swa_sample_unit(LAS unsigned char* lds, const Ptrs& P, int b) {
    const int tid = threadIdx.x, lane = tid & 63, wid = __builtin_amdgcn_readfirstlane(tid >> 6), r32 = lane & 31, hi = lane >> 5;
    float* okb = P.out + O_KS + (size_t)b * 16384; float* ovb = P.out + O_VS + (size_t)b * 16384;
#pragma unroll
    for (int i = 0; i < 8; ++i) {
        const int q = tid + 512 * i, j = q >> 5, c4 = q & 31, kvh = c4 >> 4, d0 = (c4 & 15) * 4;
        const f32x4 kf = *(const f32x4*)(P.ck + (size_t)b * 16384 + j * 128 + c4 * 4);
        const f32x4 vf = *(const f32x4*)(P.cv + (size_t)b * 16384 + j * 128 + c4 * 4);
        if (j >= 8) { *(f32x4*)(okb + (j - 8) * 128 + c4 * 4) = kf; *(f32x4*)(ovb + (j - 8) * 128 + c4 * 4) = vf; }
        u32x2 kw; kw.x = pk2(kf[0], kf[1]); kw.y = pk2(kf[2], kf[3]);
        *(LAS u32x2*)(lds + (kvh * 160 + j) * SK_STRB + d0 * 2) = kw;
        const unsigned v01 = pk2(vf[0], vf[1]), v23 = pk2(vf[2], vf[3]);
        LAS bf16_t* vt = (LAS bf16_t*)(lds + S_OFF_V + (kvh * 64 + d0) * SV_STRB + j * 2);
        vt[0] = (bf16_t)(v01 & 0xffffu); vt[SV_STRB / 2] = (bf16_t)(v01 >> 16); vt[2 * (SV_STRB / 2)] = (bf16_t)(v23 & 0xffffu); vt[3 * (SV_STRB / 2)] = (bf16_t)(v23 >> 16);
    }
    for (int e = tid; e < 2048; e += 512) {
        const int isv = e >> 10, s = (e >> 7) & 7, c = e & 127, kvh = c >> 6, d = c & 63;
        const bf16_t raw = P.Z[(size_t)(NTP + b * 8 + s) * NIN + (isv ? ZSV : ZSK) + c];
        (isv ? ovb : okb)[(120 + s) * 128 + c] = bf2f(raw);
        if (isv) *(LAS bf16_t*)(lds + S_OFF_V + (kvh * 64 + d) * SV_STRB + (128 + s) * 2) = raw;
        else *(LAS bf16_t*)(lds + (kvh * 160 + 128 + s) * SK_STRB + d * 2) = raw;
    }
    for (int e = tid; e < 2 * 24 * 64; e += 512) {
        const int kvh = e / 1536, rem = e % 1536, jj = rem >> 6, d = rem & 63;
        *(LAS bf16_t*)(lds + (kvh * 160 + 136 + jj) * SK_STRB + d * 2) = 0;
        *(LAS bf16_t*)(lds + S_OFF_V + (kvh * 64 + d) * SV_STRB + (136 + jj) * 2) = 0;
    }
    __syncthreads();
    if (wid < 2) {
        const int kvh = wid, g = r32 >> 3, s = r32 & 7, qh = kvh * 4 + g;
        const size_t row = (size_t)NTP + b * 8 + s;
        auto valid = [=](int jr) { return jr < 128 ? (jr > s) : (jr - 128 <= s); };
        swa_tile(lds + kvh * 160 * SK_STRB, SK_STRB, lds + S_OFF_V + kvh * 64 * SV_STRB, SV_STRB, P.Z + row * NIN + ZSQ + qh * 64, P.sinks[qh], valid, P.MIX + row * DM + 512 + qh * 64, r32, hi);
    }
    __syncthreads();
}

DI void hgrn_sample_unit(LAS unsigned char* lds, const Ptrs& P, int unit) {
    const int tid = threadIdx.x, lane = tid & 63, wid = __builtin_amdgcn_readfirstlane(tid >> 6), hi = lane >> 5;
    const int b = unit >> 2, h = unit & 3;
    LAS float* Fs = (LAS float*)lds; LAS float* Ks = Fs + 1024; LAS float* Qs = Ks + 1024; LAS float* Vs = Qs + 1024; LAS float* Gs = Vs + 1024; LAS float* OP = Gs + 1024;
    for (int e = tid; e < 1024; e += 512) {
        const int t = e >> 7, d = e & 127;
        const bf16_t* zr = P.Z + (size_t)(NTP + b * 8 + t) * NIN + h * 128 + d;
        const float zq = bf2f(zr[ZQ]), zi = bf2f(zr[ZI]), zg = bf2f(zr[ZG]); float zf = bf2f(zr[ZF]); zf = fminf(fmaxf(zf, -30.f), 30.f);
        const float l0 = P.lb_logits[h * 128 + d], l1 = P.lb_logits[512 + h * 128 + d];
        const float lbv = 1.f / (1.f + __expf(l1 - l0)), oml = 1.f - lbv;
        const float ex = __expf(-zf), sg = 1.f / (1.f + ex);
        Fs[e] = lbv + oml * sg; Ks[e] = oml * ex * sg; Qs[e] = zq / (1.f + __expf(-zq)); Vs[e] = zi; Gs[e] = zg / (1.f + __expf(-zg));
    }
    __syncthreads();
    const int dg = tid >> 5, vq = tid & 31;
    const size_t soff = ((size_t)unit * 128 + dg * 8) * 128 + vq * 4;
    f32x4 S[8];
#pragma unroll
    for (int i = 0; i < 8; ++i) S[i] = *(const f32x4*)(P.state + soff + i * 128);
#pragma unroll 1
    for (int t = 0; t < 8; ++t) {
        const f32x4 v = *(const LAS f32x4*)(Vs + t * 128 + vq * 4); f32x4 op = (f32x4){0.f, 0.f, 0.f, 0.f};
#pragma unroll
        for (int i = 0; i < 8; ++i) { const int d = dg * 8 + i; const float f = Fs[t * 128 + d], k = Ks[t * 128 + d], q = Qs[t * 128 + d];
            S[i] = S[i] * f + v * k; op += S[i] * q; }
#pragma unroll
        for (int j = 0; j < 4; ++j) op[j] += __shfl_xor(op[j], 32);
        if (hi == 0) *(LAS f32x4*)(OP + (t * 8 + wid) * 128 + vq * 4) = op;
    }
    float* so = P.out + O_SS + soff;
#pragma unroll
    for (int i = 0; i < 8; ++i) *(f32x4*)(so + i * 128) = S[i];
    __syncthreads();
    {
        const int t = wid; float o0 = 0.f, o1 = 0.f;
#pragma unroll
        for (int w = 0; w < 8; ++w) { o0 += OP[(t * 8 + w) * 128 + lane]; o1 += OP[(t * 8 + w) * 128 + 64 + lane]; }
        const float rstd = rsqrtf(wave_sum(o0 * o0 + o1 * o1) * (1.f / 128.f) + EPS);
        bf16_t* mo = P.MIX + (size_t)(NTP + b * 8 + t) * DM + h * 128;
        mo[lane] = (bf16_t)(pk2(o0 * rstd * P.hg_norm[lane] * Gs[t * 128 + lane], 0.f) & 0xffffu);
        mo[64 + lane] = (bf16_t)(pk2(o1 * rstd * P.hg_norm[64 + lane] * Gs[t * 128 + 64 + lane], 0.f) & 0xffffu);
    }
    __syncthreads();
}

DI void scan_phase(const Ptrs& P, int G, int skip) {
    if ((int)blockIdx.x < skip) return;
    const int gt = ((int)blockIdx.x - skip) * 512 + threadIdx.x, NT = (G - skip) * 512;
    for (int idx4 = gt; idx4 < 32 * 4096; idx4 += NT) {
        const int bh = idx4 >> 12, e = (idx4 & 4095) * 4, d = e >> 7;
        float* hp = P.HS + (size_t)bh * 32 * 16384 + e; const float* dp = P.DSC + bh * 32 * 128 + d;
        f32x4 S = (f32x4){0.f, 0.f, 0.f, 0.f};
#pragma unroll 1
        for (int s0 = 0; s0 < 32; s0 += 8) {
            f32x4 Hv[8]; float dv[8];
#pragma unroll
            for (int j = 0; j < 8; ++j) { Hv[j] = *(const f32x4*)(hp + (size_t)(s0 + j) * 16384); dv[j] = dp[(s0 + j) * 128]; }
#pragma unroll
            for (int j = 0; j < 8; ++j) { *(f32x4*)(hp + (size_t)(s0 + j) * 16384) = S; S = S * dv[j] + Hv[j]; }
        }
        *(f32x4*)(P.out + O_SP + (size_t)bh * 16384 + e) = S;
    }
    for (int e = gt; e < 8 * 128 * 256; e += NT) {
        const int b = e >> 15, j = (e >> 8) & 127, c = e & 255;
        const float v = bf2f(P.Z[(size_t)(b * SEQ + SEQ - 128 + j) * NIN + ZSK + c]);
        if (c < 128) P.out[O_KP + (size_t)(b * 128 + j) * 128 + c] = v; else P.out[O_VP + (size_t)(b * 128 + j) * 128 + (c - 128)] = v;
    }
}

DI void final_norm(const Ptrs& P, int G) {
    const int tid = threadIdx.x, lane = tid & 63, wave = tid >> 6;
    const int gw = blockIdx.x * 8 + wave, NGW = G * 8;
    f32x4 gv[4];
#pragma unroll
    for (int j = 0; j < 4; ++j) gv[j] = *((const f32x4*)P.ln_final + lane + 64 * j);
    for (int m = gw; m < M; m += NGW) {
        f32x4* yr = (f32x4*)(P.out + (size_t)m * DM) + lane;
        f32x4 v[4]; float s = 0.f;
#pragma unroll
        for (int j = 0; j < 4; ++j) v[j] = yr[64 * j];
        if (m >= NTP) {
#pragma unroll 4
            for (int sl = 0; sl < 16; ++sl) { const f32x4* pr = (const f32x4*)(P.PART + ((size_t)sl * NTS + (m - NTP)) * DM) + lane;
#pragma unroll
                for (int j = 0; j < 4; ++j) v[j] += pr[64 * j]; }
        }
#pragma unroll
        for (int j = 0; j < 4; ++j) s += (v[j].x * v[j].x + v[j].y * v[j].y) + (v[j].z * v[j].z + v[j].w * v[j].w);
        const float rstd = rsqrtf(wave_sum(s) * (1.f / DM) + EPS);
#pragma unroll
        for (int j = 0; j < 4; ++j) yr[64 * j] = v[j] * rstd * gv[j];
    }
}

#define XB_TMO      128
#define XB_XCNT(j)  (256  + 64 * (j))
#define XB_XSUB(j)  (1280 + 64 * (j))
#define XB_XGEN(j)  (2304 + 64 * (j))
#define XB_TOP      3328
#define XB_TOPGEN   3392
#define XCD_BAR_WORDS 3456
#define XB_SPIN_CAP (1u << 18)
DI unsigned xb_ld(unsigned* p)              { return __hip_atomic_load(p, __ATOMIC_RELAXED, __HIP_MEMORY_SCOPE_AGENT); }
DI unsigned xb_add(unsigned* p, unsigned v) { return __hip_atomic_fetch_add(p, v, __ATOMIC_RELAXED, __HIP_MEMORY_SCOPE_AGENT); }
DI unsigned xb_xcc_id() { return (unsigned)__builtin_amdgcn_s_getreg((3 << 11) | 20) & 0xFu; }
#define XB_SPIN(cond, bar) do { unsigned _sp = 0; while (cond) { __builtin_amdgcn_s_sleep(1); \
    if ((++_sp & 255u) == 0u) { if (xb_ld(&(bar)[XB_TMO])) break; if (_sp > XB_SPIN_CAP) { atomicAdd(&(bar)[XB_TMO], 1u); break; } } } } while (0)
struct XcdBarrier { unsigned* bar; unsigned x; volatile LAS unsigned* st; };
DI XcdBarrier xcd_barrier_post(unsigned* bar, volatile LAS unsigned* st) {
    XcdBarrier b; b.bar = bar; b.x = xb_xcc_id(); b.st = st;
    if (threadIdx.x == 0) (void)xb_add(&bar[XB_XCNT(b.x)], 1u);
    return b;
}
DI void xcd_barrier_complete(unsigned* bar, unsigned x, unsigned& nloc, unsigned& nx) {
    const unsigned G = gridDim.x * gridDim.y * gridDim.z;
    unsigned sum, cnt, mine, sp = 0u;
    for (;;) {
        sum = 0u; cnt = 0u; mine = 0u;
#pragma unroll
        for (unsigned j = 0; j < 16; ++j) { const unsigned c = xb_ld(&bar[XB_XCNT(j)]); sum += c; cnt += (c > 0u) ? 1u : 0u; mine = (j == x) ? c : mine; }
        if (sum == G) break;
        __builtin_amdgcn_s_sleep(1);
        if ((++sp & 255u) == 0u) { if (xb_ld(&bar[XB_TMO])) break; if (sp > XB_SPIN_CAP) { atomicAdd(&bar[XB_TMO], 1u); break; } }
    }
    nloc = mine > 0u ? mine : 1u; nx = cnt > 0u ? cnt : 1u;
}
DI void xcd_barrier(const XcdBarrier& b) {
    asm volatile("s_waitcnt vmcnt(0)" ::: "memory");
    __syncthreads();
    if (threadIdx.x == 0) {
        unsigned* bar = b.bar;
        __builtin_amdgcn_s_waitcnt(0);
        unsigned nloc = b.st[0], nx = b.st[1];
        if (nloc == 0u) { xcd_barrier_complete(bar, b.x, nloc, nx); b.st[0] = nloc; b.st[1] = nx; }
        const unsigned old = xb_add(&bar[XB_XSUB(b.x)], 1u);
        const unsigned gen = old / nloc;
        if (old + 1u == (gen + 1u) * nloc) {
            __builtin_amdgcn_fence(__ATOMIC_RELEASE, "agent");
            asm volatile("s_waitcnt vmcnt(0)" ::: "memory");
            const unsigned og = xb_add(&bar[XB_TOP], 1u);
            const unsigned tg = og / nx;
            if (og + 1u == (tg + 1u) * nx) xb_add(&bar[XB_TOPGEN], 1u);
            else XB_SPIN(xb_ld(&bar[XB_TOPGEN]) == tg, bar);
            __builtin_amdgcn_fence(__ATOMIC_ACQUIRE, "agent");
            xb_add(&bar[XB_XGEN(b.x)], 1u);
            asm volatile("s_waitcnt vmcnt(0)" ::: "memory");
        } else {
            XB_SPIN(xb_ld(&bar[XB_XGEN(b.x)]) == gen, bar);
            __builtin_amdgcn_fence(__ATOMIC_ACQUIRE, "agent");
            asm volatile("s_waitcnt vmcnt(0)" ::: "memory");
        }
    }
    __syncthreads();
}

struct Args { const float* in[15]; float* out; unsigned char* ws; int ph_lo, ph_hi; };
constexpr int NPHASE = 9;

__global__ void __launch_bounds__(512, 2) mk_fwd(Args args) {
    extern __shared__ __attribute__((aligned(16))) unsigned char lds_raw[];
    LAS unsigned char* lds = (LAS unsigned char*)lds_raw;
    cg::grid_group grid = cg::this_grid();
    const int G = gridDim.x;
    Ptrs P;
    P.x_p = args.in[0]; P.x_s = args.in[1]; P.state = args.in[2]; P.ck = args.in[3]; P.cv = args.in[4]; P.ln_mix = args.in[5]; P.w_in = args.in[6]; P.lb_logits = args.in[7];
    P.hg_norm = args.in[8]; P.sinks = args.in[9]; P.w_out = args.in[10]; P.ln_mlp = args.in[11]; P.w_up = args.in[12]; P.w_down = args.in[13]; P.ln_final = args.in[14];
    P.out = args.out;
    unsigned char* ws = args.ws;
    P.WinT = (bf16_t*)(ws + WS_WIN); P.WoutT = (bf16_t*)(ws + WS_WOUT); P.WupT = (bf16_t*)(ws + WS_WUP); P.WdnT = (bf16_t*)(ws + WS_WDN);
    P.XN = (bf16_t*)(ws + WS_XN); P.Z = (bf16_t*)(ws + WS_Z); P.MIX = (bf16_t*)(ws + WS_MIX); P.U = (bf16_t*)(ws + WS_U);
    P.HS = (float*)(ws + WS_HS); P.DSC = (float*)(ws + WS_DSC); P.rss1 = (float*)(ws + WS_RSS1); P.rss2 = (float*)(ws + WS_RSS2); P.PART = (float*)(ws + WS_PART);
    const int lo = args.ph_lo, hi = args.ph_hi;
    unsigned* barw = (unsigned*)(ws + WS_BAR);
    volatile LAS unsigned* misc = (volatile LAS unsigned*)(lds + LDS_MISC);
    if (threadIdx.x < 2) misc[threadIdx.x] = 0u;
    if (blockIdx.x == 0) for (int i = threadIdx.x; i < XCD_BAR_WORDS; i += 512) __hip_atomic_store(barw + i, 0u, __ATOMIC_RELAXED, __HIP_MEMORY_SCOPE_AGENT);
    XcdBarrier xbar; xbar.bar = barw; xbar.x = 0; xbar.st = misc;
#define IN(k) (lo <= (k) && (k) < hi)
#define SEAM(k) do { if (IN(k) && IN((k) + 1)) { if ((k) == 0) { grid.sync(); xbar = xcd_barrier_post(barw, misc); } else xcd_barrier(xbar); } } while (0)
    if (IN(0)) { p0_prologue(lds, P, G); if (PROBE_P0) { __syncthreads(); p0_prologue(lds, P, G); } }
    SEAM(0);
    if (PROBE_SYNC) { for (int i = 0; i < 8; ++i) grid.sync(); }
    if (IN(1)) { pg8::Gemm g{P.XN, P.WinT, DM, DM / 64}; pg8::StaticOrder S; S.init(M, NIN, G, (int)blockIdx.x); pg8::EpiZ E{P.Z, NIN};
        pg8::gemm_phase<pg8::EpiZ, pg8::StaticOrder, true>(lds, g, S, E); }
    SEAM(1);
    if (IN(2)) {
        for (int rep = 0; rep < 1 + PROBE_P2A; ++rep)
        for (int u = blockIdx.x; u < 1024; u += G) hgrn_unit<false>(lds, P, u);
        for (int rep = 0; rep < 1 + PROBE_P2A; ++rep) {
        for (int u = blockIdx.x; u < 512; u += G) swa_prompt_unit(lds, P, u);
        for (int u = blockIdx.x; u < 512; u += G) hgrn_sample_unit(lds, P, u);
        for (int u = blockIdx.x; u < 128; u += G) swa_sample_unit(lds, P, u); }
    }
    SEAM(2);
    if (IN(3)) {
        { pg8::Gemm g{P.MIX, P.WoutT, DM, DM / 64}; pg8::RectOrder S; S.init(NTP / 256, NTS / 256, DM / 256, 1, DM / 64, G, (int)blockIdx.x); pg8::EpiRes1 E{P.x_p, P.x_s, P.out, P.XN, P.rss1};
          pg8::gemm_phase<pg8::EpiRes1, pg8::RectOrder, true>(lds, g, S, E); }
        scan_phase(P, G, G > 32 ? 16 : 0);
    }
    SEAM(3);
    if (IN(4)) { for (int rep = 0; rep < 1 + PROBE_P2C; ++rep) for (int u = blockIdx.x; u < 1024; u += G) hgrn_unit<true>(lds, P, u); }
    SEAM(4);
    if (IN(5)) {
        { pg8::Gemm g{P.MIX, P.WoutT, DM, DM / 64}; pg8::StaticOrder S; S.init(NTP, DM, G, (int)blockIdx.x); pg8::EpiRes1 E{P.x_p, P.x_s, P.out, P.XN, P.rss1};
          pg8::gemm_phase<pg8::EpiRes1, pg8::StaticOrder, true>(lds, g, S, E); }
        { pg8::Gemm g{P.XN, P.WupT, DM, DM / 64}; pg8::RectOrder S; S.init(NTP / 256, NTS / 256, FF / 256, 1, DM / 64, G, (int)blockIdx.x); pg8::EpiUp E{P.U, FF, P.rss1};
          pg8::gemm_phase<pg8::EpiUp, pg8::RectOrder, true>(lds, g, S, E); }
    }
    SEAM(5);
    if (IN(6)) {
        { pg8::Gemm g{P.XN, P.WupT, DM, DM / 64}; pg8::StaticOrder S; S.init(NTP, FF, G, (int)blockIdx.x); pg8::EpiUp E{P.U, FF, P.rss1};
          pg8::gemm_phase<pg8::EpiUp, pg8::StaticOrder, true>(lds, g, S, E); }
        { pg8::Gemm g{P.U, P.WdnT, FF, 4}; pg8::RectOrder S; S.init(NTP / 256, NTS / 256, DM / 256, 16, 4, G, (int)blockIdx.x); pg8::EpiDown<true> E{P.out, P.PART};
          pg8::gemm_phase<pg8::EpiDown<true>, pg8::RectOrder, true, true>(lds, g, S, E); }
    }
    SEAM(6);
    if (IN(7)) { pg8::Gemm g{P.U, P.WdnT, FF, FF / 64}; pg8::StaticOrder S; S.init(NTP, DM, G, (int)blockIdx.x); pg8::EpiDown<false> E{P.out, nullptr};
        pg8::gemm_phase<pg8::EpiDown<false>, pg8::StaticOrder, true>(lds, g, S, E); }
    SEAM(7);
    if (IN(8)) { final_norm(P, G); }
#undef IN
#undef SEAM
}

extern "C" void kernel_launch(void* const* d_in, const int* in_sizes, int n_in, void* d_out, int out_size, void* d_ws, size_t ws_size, hipStream_t stream) {
    static int grid = 0;
    if (grid == 0) {
        if (n_in != 15 || (size_t)out_size != O_END || ws_size < WS_END) { fprintf(stderr, "kernel_launch: unexpected shapes (n_in %d out %d ws %zu)\n", n_in, out_size, ws_size); grid = -1; return; }
        int dev = 0, cus = 0, per_cu = 0;
        (void)hipGetDevice(&dev); (void)hipDeviceGetAttribute(&cus, hipDeviceAttributeMultiprocessorCount, dev);
        if (hipFuncSetAttribute((const void*)mk_fwd, hipFuncAttributeMaxDynamicSharedMemorySize, LDS_BYTES) != hipSuccess) { fprintf(stderr, "kernel_launch: hipFuncSetAttribute failed\n"); grid = -1; return; }
        if (hipOccupancyMaxActiveBlocksPerMultiprocessor(&per_cu, (const void*)mk_fwd, 512, LDS_BYTES) != hipSuccess || per_cu < 1) { fprintf(stderr, "kernel_launch: occupancy query says %d\n", per_cu); per_cu = 1; }
        (void)hipGetLastError();
        if (per_cu > 1) per_cu = 1;
        grid = cus * per_cu;
    }
    if (grid < 0) return;
    Args a{};
    for (int i = 0; i < 15; ++i) a.in[i] = (const float*)d_in[i];
    a.out = (float*)d_out; a.ws = (unsigned char*)d_ws;
#if MK_COOP
    a.ph_lo = 0; a.ph_hi = NPHASE;
    void* kargs[] = {&a};
    hipError_t e = hipLaunchCooperativeKernel((const void*)mk_fwd, dim3(grid), dim3(512), kargs, LDS_BYTES, stream);
    if (e != hipSuccess) fprintf(stderr, "cooperative launch failed: %s (grid %d)\n", hipGetErrorString(e), grid);
#else
    for (int p = 0; p < NPHASE; ++p) { a.ph_lo = p; a.ph_hi = p + 1; hipLaunchKernelGGL(mk_fwd, dim3(grid), dim3(512), LDS_BYTES, stream, a); }
#endif
}
```

```cpp
#include <hip/hip_runtime.h>
#include <hip/hip_cooperative_groups.h>
#include <cstdio>
#include <cstdint>
namespace cg = cooperative_groups;

#ifndef MK_COOP
#define MK_COOP 1
#endif
#define PROBE_P0 0
#define PROBE_P2A 0
#define PROBE_P2C 0
#define PROBE_SYNC 0

#define DI __device__ __forceinline__
#define LAS __attribute__((address_space(3)))
typedef unsigned short bf16_t;
typedef short bf16x8 __attribute__((ext_vector_type(8)));
typedef short s16x4 __attribute__((ext_vector_type(4)));
typedef float f32x4 __attribute__((ext_vector_type(4)));
typedef float f32x16 __attribute__((ext_vector_type(16)));
typedef unsigned u32x4 __attribute__((ext_vector_type(4)));
typedef unsigned u32x2 __attribute__((ext_vector_type(2)));
typedef float f32x2_t __attribute__((ext_vector_type(2)));
typedef __bf16 bf16x2_t __attribute__((ext_vector_type(2)));

DI unsigned pk2(float lo, float hi) { f32x2_t v = {lo, hi}; bf16x2_t b = __builtin_convertvector(v, bf16x2_t); return __builtin_bit_cast(unsigned, b); }
DI float bf2f(bf16_t v) { return __uint_as_float(((unsigned)v) << 16); }
DI float bflo(unsigned w) { return __uint_as_float(w << 16); }
DI float bfhi(unsigned w) { return __uint_as_float(w & 0xffff0000u); }
DI int crow(int reg, int h) { return (reg & 3) + 8 * (reg >> 2) + 4 * h; }
#define MFMA32(a, b, c) __builtin_amdgcn_mfma_f32_32x32x16_bf16((a), (b), (c), 0, 0, 0)
DI bf16x8 packs(const f32x16& x, int s) {
    u32x4 p; p.x = pk2(x[8 * s], x[8 * s + 1]); p.y = pk2(x[8 * s + 2], x[8 * s + 3]); p.z = pk2(x[8 * s + 4], x[8 * s + 5]); p.w = pk2(x[8 * s + 6], x[8 * s + 7]);
    return __builtin_bit_cast(bf16x8, p);
}
DI bf16x8 cat4(s16x4 lo, s16x4 hi) { return __builtin_shufflevector(lo, hi, 0, 1, 2, 3, 4, 5, 6, 7); }
DI float wave_sum(float v) {
#pragma unroll
    for (int o = 1; o < 64; o <<= 1) v += __shfl_xor(v, o);
    return v;
}

constexpr int DM = 1024, SEQ = 4096, NB = 8, NTP = NB * SEQ, DB = 128, DS = 8, NTS = DB * DS, M = NTP + NTS;
constexpr int NIN = 2816, FF = 4096;
constexpr int ZQ = 0, ZF = 512, ZI = 1024, ZG = 1536, ZSQ = 2048, ZSK = 2560, ZSV = 2688;
constexpr float EPS = 1e-6f;
constexpr size_t O_Y = 0, O_SP = (size_t)M * DM, O_KP = O_SP + 8 * 4 * 128 * 128, O_VP = O_KP + 8 * 128 * 128, O_SS = O_VP + 8 * 128 * 128,
                 O_KS = O_SS + (size_t)128 * 4 * 128 * 128, O_VS = O_KS + (size_t)128 * 128 * 128, O_END = O_VS + (size_t)128 * 128 * 128;
constexpr size_t MiB = 1u << 20;
constexpr size_t WS_RSS1 = 0, WS_RSS2 = 256 * 1024, WS_BAR = 512 * 1024, WS_WIN = 1 * MiB, WS_WOUT = 7 * MiB, WS_WUP = 9 * MiB, WS_WDN = 17 * MiB, WS_DSC = 25 * MiB,
                 WS_XN = 26 * MiB, WS_Z = 92 * MiB, WS_MIX = 274 * MiB, WS_HS = 340 * MiB, WS_U = 92 * MiB, WS_PART = 404 * MiB, WS_END = 468 * MiB;
static_assert(WS_XN + (size_t)M * DM * 2 <= WS_Z && WS_Z + (size_t)M * NIN * 2 <= WS_MIX && WS_MIX + (size_t)M * DM * 2 <= WS_HS && WS_U + (size_t)M * FF * 2 <= WS_END, "ws map");
constexpr int LDS_BYTES = 155648, LDS_MISC = LDS_BYTES - 64;

namespace pg8 {
constexpr int BM = 256, BK = 64, HALF = 128, HTB = HALF * BK * 2, STAGE_BYTES = 8 * HTB, NXCD = 8, WGM = 8;
DI int lds_byte(int r, int c) { const int st = (r >> 4) * 2 + (c >> 5), rr = r & 15, cc = c & 31, ob = rr * 64 + cc * 2; return st * 1024 + (ob ^ (((ob >> 9) & 1) << 5)); }
DI void stage_rc(int b, int& R, int& C) { const int st = b / 1024, sb = b % 1024, swz = sb ^ (((sb >> 9) & 1) << 5); R = (st >> 1) * 16 + swz / 64; C = (st & 1) * 32 + (swz % 64) / 2; }
DI int perm32(int rho) { const int n = rho >> 4, i = rho & 15; return 8 * (i >> 2) + 4 * n + (i & 3); }
struct Unit { int pm, pn, kt0; };
struct Gemm { const bf16_t* A; const bf16_t* Bt; int K, nt; };
struct StaticOrder {
    int nM, nN, nwg, G, c;
    DI void init(int M_, int N_, int G_, int c_) { nM = M_ / BM; nN = N_ / BM; nwg = nM * nN; G = G_; c = c_; }
    DI bool next(int i, Unit& u) const {
        const long L = (long)i * G + c; if (L >= nwg) return false;
        int wgid = (int)L; { const int q = nwg / NXCD, r = nwg % NXCD, xcd = wgid % NXCD, off = wgid / NXCD; wgid = (xcd < r ? xcd * (q + 1) : r * (q + 1) + (xcd - r) * q) + off; }
        const int nig = WGM * nN, gid = wgid / nig, fm = gid * WGM, gsz = (nM - fm) < WGM ? (nM - fm) : WGM;
        u.pm = fm + ((wgid % nig) % gsz); u.pn = (wgid % nig) / gsz; u.kt0 = 0; return true;
    }
};
struct RectOrder {
    int pm0, nN, nslice, nt, total, G, c;
    DI void init(int pm0_, int nPm, int nN_, int nslice_, int nt_, int G_, int c_) { pm0 = pm0_; nN = nN_; nslice = nslice_; nt = nt_; total = nPm * nN_ * nslice_; G = G_; c = c_; }
    DI bool next(int i, Unit& u) const {
        const long L = (long)i * G + c; if (L >= total) return false;
        const int sl = (int)L % nslice, t = (int)L / nslice; u.pn = t % nN; u.pm = pm0 + t / nN; u.kt0 = sl * nt; return true;
    }
};
struct EpiZ {
    static constexpr bool PERM = true;
    bf16_t* O; int ldc;
    DI void operator()(const f32x4 (&acc)[2][2][4][2], const Unit& u, int wr, int wc, int fr, int fq) const {
        const int row0 = u.pm * BM + wr * 64 + fr, col0 = u.pn * BM + wc * 32 + 8 * fq;
#pragma unroll
        for (int ai = 0; ai < 2; ++ai)
#pragma unroll
            for (int m = 0; m < 4; ++m) { bf16_t* rowp = O + (size_t)(row0 + ai * HALF + m * 16) * ldc + col0;
#pragma unroll
                for (int bj = 0; bj < 2; ++bj) { const f32x4 v0 = acc[ai][bj][m][0], v1 = acc[ai][bj][m][1];
                    u32x4 w; w.x = pk2(v0[0], v0[1]); w.y = pk2(v0[2], v0[3]); w.z = pk2(v1[0], v1[1]); w.w = pk2(v1[2], v1[3]);
                    *(u32x4*)(rowp + bj * HALF) = w; } }
    }
};
struct EpiUp {
    static constexpr bool PERM = true;
    bf16_t* O; int ldc; const float* rowss;
    DI void operator()(const f32x4 (&acc)[2][2][4][2], const Unit& u, int wr, int wc, int fr, int fq) const {
        const int row0 = u.pm * BM + wr * 64 + fr, col0 = u.pn * BM + wc * 32 + 8 * fq;
#pragma unroll
        for (int ai = 0; ai < 2; ++ai)
#pragma unroll
            for (int m = 0; m < 4; ++m) { const int r = row0 + ai * HALF + m * 16; bf16_t* rowp = O + (size_t)r * ldc + col0;
                const float rs = rsqrtf(rowss[r] * (1.0f / DM) + EPS);
#pragma unroll
                for (int bj = 0; bj < 2; ++bj) { f32x4 v0 = acc[ai][bj][m][0] * rs, v1 = acc[ai][bj][m][1] * rs;
#pragma unroll
                    for (int j = 0; j < 4; ++j) { const float a = fmaxf(v0[j], 0.f), b = fmaxf(v1[j], 0.f); v0[j] = a * a; v1[j] = b * b; }
                    u32x4 w; w.x = pk2(v0[0], v0[1]); w.y = pk2(v0[2], v0[3]); w.z = pk2(v1[0], v1[1]); w.w = pk2(v1[2], v1[3]);
                    *(u32x4*)(rowp + bj * HALF) = w; } }
    }
};
struct EpiRes1 {
    static constexpr bool PERM = false;
    const float* xp; const float* xs; float* out; bf16_t* hb; float* rowss;
    DI void operator()(const f32x4 (&acc)[2][2][4][2], const Unit& u, int wr, int wc, int fr, int fq) const {
        const int col0 = u.pn * BM + wc * 32 + 4 * fq;
#pragma unroll
        for (int ai = 0; ai < 2; ++ai)
#pragma unroll
            for (int m = 0; m < 4; ++m) { const int r = u.pm * BM + ai * HALF + wr * 64 + m * 16 + fr;
                const float* base = r < NTP ? xp + (size_t)r * DM : xs + (size_t)(r - NTP) * DM;
                float* orow = out + (size_t)r * DM; float ss = 0.f;
#pragma unroll
                for (int bj = 0; bj < 2; ++bj)
#pragma unroll
                    for (int n = 0; n < 2; ++n) { const int c = col0 + bj * HALF + n * 16; const f32x4 o = *(const f32x4*)(base + c) + acc[ai][bj][m][n];
                        ss += (o[0] * o[0] + o[1] * o[1]) + (o[2] * o[2] + o[3] * o[3]); *(f32x4*)(orow + c) = o;
                        u32x2 w; w.x = pk2(o[0], o[1]); w.y = pk2(o[2], o[3]); *(u32x2*)(hb + (size_t)r * DM + c) = w; }
                ss += __shfl_xor(ss, 16); ss += __shfl_xor(ss, 32);
                if (fq == 0) unsafeAtomicAdd(rowss + r, ss); }
    }
};
template <bool PARTIAL> struct EpiDown {
    static constexpr bool PERM = false;
    float* out; float* part;
    DI void operator()(const f32x4 (&acc)[2][2][4][2], const Unit& u, int wr, int wc, int fr, int fq) const {
        const int col0 = u.pn * BM + wc * 32 + 4 * fq;
#pragma unroll
        for (int ai = 0; ai < 2; ++ai)
#pragma unroll
            for (int m = 0; m < 4; ++m) { const int r = u.pm * BM + ai * HALF + wr * 64 + m * 16 + fr;
                float* orow = PARTIAL ? part + ((size_t)(u.kt0 >> 2) * NTS + (size_t)(r - NTP)) * DM : out + (size_t)r * DM;
#pragma unroll
                for (int bj = 0; bj < 2; ++bj)
#pragma unroll
                    for (int n = 0; n < 2; ++n) { const int c = col0 + bj * HALF + n * 16;
                        if (PARTIAL) *(f32x4*)(orow + c) = acc[ai][bj][m][n];
                        else *(f32x4*)(orow + c) = *(const f32x4*)(orow + c) + acc[ai][bj][m][n]; } }
    }
};

template <class Epi, class Sched, bool ALIGN_EPI = true, bool OPAQUE_NT = false>
DI void gemm_phase(LAS unsigned char* lds, const Gemm g, const Sched& S, const Epi& E) {
    const int tid = threadIdx.x, wid = __builtin_amdgcn_readfirstlane(tid >> 6), lane = tid & 63, wr = wid >> 2, wc = wid & 3, fr = lane & 15, fq = lane >> 4;
    const int K = g.K; int nt = g.nt; if (OPAQUE_NT) asm volatile("" : "+s"(nt));
    unsigned voffA[2], voffB[2];
#pragma unroll
    for (int i = 0; i < 2; ++i) { int R, C; stage_rc(tid * 16 + i * 8192, R, C); const int Rb = Epi::PERM ? ((R & ~31) + perm32(R & 31)) : R;
        voffA[i] = (unsigned)(R * K + C) * 2u; voffB[i] = (unsigned)(Rb * K + C) * 2u; }
    const size_t kstep = (size_t)(BK * 2);
    const size_t hstep = (size_t)HALF * K * 2;
    const size_t tstep = 2 * hstep;
    const unsigned ldsw = (unsigned)wid * 1024u;
    const int aoff = lds_byte(wr * 64 + fr, fq * 8), boff = lds_byte(wc * 32 + fr, fq * 8);
#define PG8_SA(b, h) (((b) * 2 + (h)) * HTB)
#define PG8_SB(b, h) ((4 + (b) * 2 + (h)) * HTB)
#define PG8_STAGE(bufoff, gbase, voff) do { _Pragma("unroll") for (int _i = 0; _i < 2; ++_i) \
        __builtin_amdgcn_global_load_lds((const unsigned*)((const char*)(gbase) + (voff)[_i]), (LAS unsigned*)(lds + (bufoff) + ldsw + _i * 8192), 16, 0, 0); } while (0)
#define PG8_LDA(dst, b, h) do { _Pragma("unroll") for (int m = 0; m < 4; ++m) _Pragma("unroll") for (int k = 0; k < 2; ++k) dst[m][k] = *(const LAS bf16x8*)(lds + PG8_SA(b, h) + aoff + m * 2048 + k * 1024); } while (0)
#define PG8_LDB(dst, b, h) do { _Pragma("unroll") for (int n = 0; n < 2; ++n) _Pragma("unroll") for (int k = 0; k < 2; ++k) dst[n][k] = *(const LAS bf16x8*)(lds + PG8_SB(b, h) + boff + n * 2048 + k * 1024); } while (0)
#define PG8_MMA(ai, bj, At, Bt) do { __builtin_amdgcn_s_setprio(1); _Pragma("unroll") for (int m = 0; m < 4; ++m) _Pragma("unroll") for (int n = 0; n < 2; ++n) _Pragma("unroll") for (int k = 0; k < 2; ++k) \
        acc[ai][bj][m][n] = __builtin_amdgcn_mfma_f32_16x16x32_bf16(Bt[n][k], At[m][k], acc[ai][bj][m][n], 0, 0, 0); __builtin_amdgcn_s_setprio(0); } while (0)
#define PG8_WAIT_V(n) asm volatile("s_waitcnt vmcnt(" #n ")" ::: "memory")
#define PG8_WAIT_L(n) asm volatile("s_waitcnt lgkmcnt(" #n ")" ::: "memory")
#define PG8_BAR __builtin_amdgcn_s_barrier()
#define PG8_SCHED __builtin_amdgcn_sched_barrier(0)
    Unit cur, nxt; int ui = 0;
    if (!S.next(0, cur)) return;
    f32x4 acc[2][2][4][2];
#pragma unroll
    for (int a = 0; a < 2; ++a)
#pragma unroll
        for (int b = 0; b < 2; ++b)
#pragma unroll
            for (int m = 0; m < 4; ++m)
#pragma unroll
                for (int n = 0; n < 2; ++n) acc[a][b][m][n] = (f32x4){0.f, 0.f, 0.f, 0.f};
    bf16x8 At[4][2], B0[2][2], B1[2][2];
    const char* cA = (const char*)g.A + (size_t)cur.pm * tstep + (size_t)cur.kt0 * kstep; const char* cB = (const char*)g.Bt + (size_t)cur.pn * tstep + (size_t)cur.kt0 * kstep;
    PG8_STAGE(PG8_SB(0, 0), cB, voffB); PG8_STAGE(PG8_SB(0, 1), cB + hstep, voffB); PG8_STAGE(PG8_SA(0, 0), cA, voffA); PG8_STAGE(PG8_SA(0, 1), cA + hstep, voffA);
    if (wr == 1) PG8_BAR;
    PG8_WAIT_V(2); PG8_BAR;
    PG8_STAGE(PG8_SB(1, 0), cB + kstep, voffB); PG8_STAGE(PG8_SA(1, 0), cA + kstep, voffA); PG8_STAGE(PG8_SB(1, 1), cB + hstep + kstep, voffB);
    PG8_WAIT_V(6); PG8_BAR;
    for (;;) {
        const bool has_next = S.next(ui + 1, nxt);
        const char* nA = has_next ? (const char*)g.A + (size_t)nxt.pm * tstep + (size_t)nxt.kt0 * kstep : cA; const char* nB = has_next ? (const char*)g.Bt + (size_t)nxt.pn * tstep + (size_t)nxt.kt0 * kstep : cB;
        for (int t = 0; t < nt; t += 2) {
            const bool last = (t == nt - 2);
            const char* a1 = cA + (size_t)(t + 1) * kstep;
            const char* a2 = last ? nA : cA + (size_t)(t + 2) * kstep; const char* b2 = last ? nB : cB + (size_t)(t + 2) * kstep;
            const char* a3 = a2 + kstep; const char* b3 = b2 + kstep;
            PG8_LDB(B0, 0, 0); PG8_LDB(B1, 0, 1); PG8_SCHED; PG8_LDA(At, 0, 0); PG8_STAGE(PG8_SA(1, 1), a1 + hstep, voffA);
            PG8_WAIT_V(8); PG8_WAIT_L(0); PG8_BAR; PG8_MMA(0, 0, At, B0); PG8_MMA(0, 1, At, B1); PG8_BAR; PG8_SCHED;
            PG8_LDA(At, 0, 1); PG8_STAGE(PG8_SB(0, 0), b2, voffB); PG8_STAGE(PG8_SB(0, 1), b2 + hstep, voffB); PG8_STAGE(PG8_SA(0, 0), a2, voffA);
            PG8_WAIT_V(8); PG8_WAIT_L(0); PG8_BAR; PG8_MMA(1, 0, At, B0); PG8_MMA(1, 1, At, B1); PG8_BAR; PG8_SCHED;
            PG8_LDB(B0, 1, 0); PG8_LDB(B1, 1, 1); PG8_SCHED; PG8_LDA(At, 1, 0); PG8_STAGE(PG8_SA(0, 1), a2 + hstep, voffA);
            PG8_WAIT_V(8); PG8_WAIT_L(0); PG8_BAR; PG8_MMA(0, 0, At, B0); PG8_MMA(0, 1, At, B1); PG8_BAR; PG8_SCHED;
            PG8_LDA(At, 1, 1); PG8_STAGE(PG8_SB(1, 0), b3, voffB); PG8_STAGE(PG8_SB(1, 1), b3 + hstep, voffB); PG8_STAGE(PG8_SA(1, 0), a3, voffA);
            PG8_WAIT_V(8); PG8_WAIT_L(0); PG8_BAR; PG8_MMA(1, 0, At, B0); PG8_MMA(1, 1, At, B1); PG8_BAR; PG8_SCHED;
        }
        if constexpr (ALIGN_EPI) { if (wr == 0) PG8_BAR; }
        E(acc, cur, wr, wc, fr, fq);
        if (!has_next) break;
#pragma unroll
        for (int a = 0; a < 2; ++a)
#pragma unroll
            for (int b = 0; b < 2; ++b)
#pragma unroll
                for (int m = 0; m < 4; ++m)
#pragma unroll
                    for (int n = 0; n < 2; ++n) acc[a][b][m][n] = (f32x4){0.f, 0.f, 0.f, 0.f};
        cur = nxt; cA = nA; cB = nB; ++ui;
        if constexpr (ALIGN_EPI) { if (wr == 1) PG8_BAR; }
    }
    PG8_WAIT_V(0);
    if constexpr (!ALIGN_EPI) { if (wr == 0) PG8_BAR; }
    PG8_BAR;
#undef PG8_SA
#undef PG8_SB
#undef PG8_STAGE
#undef PG8_LDA
#undef PG8_LDB
#undef PG8_MMA
#undef PG8_WAIT_V
#undef PG8_WAIT_L
#undef PG8_BAR
#undef PG8_SCHED
}
}

struct Ptrs {
    const float *x_p, *x_s, *state, *ck, *cv, *ln_mix, *w_in, *lb_logits, *hg_norm, *sinks, *w_out, *ln_mlp, *w_up, *w_down, *ln_final;
    float* out;
    bf16_t *WinT, *WoutT, *WupT, *WdnT, *XN, *Z, *MIX, *U;
    float *HS, *DSC, *rss1, *rss2, *PART;
};

DI void p0_transpose_item(const float* W, int K, int N, bf16_t* WT, const float* kscale, LAS float* scr, int item, int lane) {
    const int nblk = N / 32, kb = item / nblk, nb = item % nblk, k0 = 64 * kb, n0 = 32 * nb;
    float wv[32];
#pragma unroll
    for (int i = 0; i < 32; ++i) wv[i] = W[(size_t)(k0 + 2 * i + (lane >> 5)) * N + n0 + (lane & 31)];
#pragma unroll
    for (int i = 0; i < 32; ++i) { const int kk = 2 * i + (lane >> 5); float v = wv[i]; if (kscale) v *= kscale[k0 + kk]; scr[kk * 33 + (lane & 31)] = v; }
    asm volatile("s_waitcnt lgkmcnt(0)" ::: "memory");
    const int c = lane & 7;
#pragma unroll
    for (int j = 0; j < 4; ++j) { const int n = (lane >> 3) + 8 * j; const LAS float* s = scr + (8 * c) * 33 + n;
        u32x4 o; o.x = pk2(s[0 * 33], s[1 * 33]); o.y = pk2(s[2 * 33], s[3 * 33]); o.z = pk2(s[4 * 33], s[5 * 33]); o.w = pk2(s[6 * 33], s[7 * 33]);
        *(u32x4*)(WT + (size_t)(n0 + n) * K + k0 + 8 * c) = o; }
    asm volatile("s_waitcnt lgkmcnt(0)" ::: "memory");
}
DI void p0_prologue(LAS unsigned char* lds, const Ptrs& P, int G) {
    const int tid = threadIdx.x, lane = tid & 63, wave = __builtin_amdgcn_readfirstlane(tid >> 6);
    LAS float* scr = (LAS float*)(lds + wave * 16384);
    const int gw = blockIdx.x * 8 + wave, NGW = G * 8;
    constexpr int I_IN = (DM / 64) * (NIN / 32), I_O = (DM / 64) * (DM / 32), I_UP = (DM / 64) * (FF / 32), I_DN = (FF / 64) * (DM / 32);
    constexpr int NITEMS = I_IN + I_O + I_UP + I_DN;
    for (int it = gw; it < NITEMS; it += NGW) {
        int r = it;
        if (r < I_IN) { p0_transpose_item(P.w_in, DM, NIN, P.WinT, nullptr, scr, r, lane); continue; } r -= I_IN;
        if (r < I_O) { p0_transpose_item(P.w_out, DM, DM, P.WoutT, nullptr, scr, r, lane); continue; } r -= I_O;
        if (r < I_UP) { p0_transpose_item(P.w_up, DM, FF, P.WupT, P.ln_mlp, scr, r, lane); continue; } r -= I_UP;
        p0_transpose_item(P.w_down, FF, DM, P.WdnT, nullptr, scr, r, lane);
    }
    f32x4 gv[4];
#pragma unroll
    for (int j = 0; j < 4; ++j) gv[j] = *((const f32x4*)P.ln_mix + lane + 64 * j);
    for (int m0 = gw; m0 < M; m0 += 2 * NGW) {
        const int m1 = m0 + NGW; const bool has1 = m1 < M; const int mm1 = has1 ? m1 : m0;
        const f32x4* xr0 = (const f32x4*)(m0 < NTP ? P.x_p + (size_t)m0 * DM : P.x_s + (size_t)(m0 - NTP) * DM) + lane;
        const f32x4* xr1 = (const f32x4*)(mm1 < NTP ? P.x_p + (size_t)mm1 * DM : P.x_s + (size_t)(mm1 - NTP) * DM) + lane;
        f32x4 v0[4], v1[4]; float s0 = 0.f, s1 = 0.f;
#pragma unroll
        for (int j = 0; j < 4; ++j) { v0[j] = xr0[64 * j]; v1[j] = xr1[64 * j]; }
#pragma unroll
        for (int j = 0; j < 4; ++j) { s0 += (v0[j].x * v0[j].x + v0[j].y * v0[j].y) + (v0[j].z * v0[j].z + v0[j].w * v0[j].w); s1 += (v1[j].x * v1[j].x + v1[j].y * v1[j].y) + (v1[j].z * v1[j].z + v1[j].w * v1[j].w); }
        const float r0 = rsqrtf(wave_sum(s0) * (1.f / DM) + EPS), r1 = rsqrtf(wave_sum(s1) * (1.f / DM) + EPS);
        unsigned long long* o0 = (unsigned long long*)(P.XN + (size_t)m0 * DM) + lane; unsigned long long* o1 = (unsigned long long*)(P.XN + (size_t)mm1 * DM) + lane;
#pragma unroll
        for (int j = 0; j < 4; ++j) { const f32x4 w = v0[j] * r0 * gv[j]; o0[64 * j] = (unsigned long long)pk2(w.x, w.y) | ((unsigned long long)pk2(w.z, w.w) << 32); }
        if (has1) {
#pragma unroll
            for (int j = 0; j < 4; ++j) { const f32x4 w = v1[j] * r1 * gv[j]; o1[64 * j] = (unsigned long long)pk2(w.x, w.y) | ((unsigned long long)pk2(w.z, w.w) << 32); }
        }
    }
    for (int i = blockIdx.x * 512 + tid; i < M; i += G * 512) P.rss1[i] = 0.f;
}

constexpr int HSTR = 136, HROWB = HSTR * 2;
constexpr int OFF_QT = 0, OFF_KT = 128 * HROWB, OFF_KET = 2 * 128 * HROWB, OFF_VT = 3 * 128 * HROWB, OFF_DEC = 4 * 128 * HROWB, OFF_SS = OFF_DEC + 2048, OFF_AT = OFF_SS + 2048;
static_assert(OFF_AT + 8192 <= LDS_MISC, "hgrn lds");
template <bool FULL>
DI void hgrn_unit(LAS unsigned char* lds, const Ptrs& P, int unit) {
    const int tid = threadIdx.x, lane = tid & 63, wid = __builtin_amdgcn_readfirstlane(tid >> 6), r32 = lane & 31, hi = lane >> 5;
    const int bh = unit >> 5, sc = unit & 31, b = bh >> 2, h = bh & 3;
    const size_t row0 = (size_t)b * SEQ + sc * 128;
    LAS float* DEC = (LAS float*)(lds + OFF_DEC);
    LAS float* SSb = (LAS float*)(lds + OFF_SS);
    const bool act = wid < 4; const int vb = wid & 3, dh = wid >> 2;
    float* HSu = P.HS + (size_t)unit * 16384;
    f32x16 S[4];
    if (FULL) {
#pragma unroll
        for (int i = 0; i < 4; ++i)
#pragma unroll
            for (int r = 0; r < 16; ++r) S[i][r] = act ? HSu[(32 * i + crow(r, hi)) * 128 + vb * 32 + r32] : 0.f;
    } else {
#pragma unroll
        for (int i = 0; i < 4; ++i)
#pragma unroll
            for (int r = 0; r < 16; ++r) S[i][r] = 0.f;
    }
    {
        const int c = tid >> 7, d = tid & 127;
        const float l0 = P.lb_logits[h * 128 + d], l1 = P.lb_logits[512 + h * 128 + d];
        const float lbv = 1.f / (1.f + __expf(l1 - l0)), oml = 1.f - lbv;
        const bf16_t* zrow = P.Z + (row0 + c * 32) * NIN + h * 128 + d;
        float ke[32];
        if (FULL) {
            float eb = 1.f;
#pragma unroll
            for (int t = 0; t < 32; ++t) {
                float zf = bf2f(zrow[(size_t)t * NIN + ZF]); zf = fminf(fmaxf(zf, -30.f), 30.f);
                const float e = __expf(-zf), sg = __builtin_amdgcn_rcpf(1.f + e);
                const float f = lbv + oml * sg, k = oml * e * sg;
                eb *= f;
                const float ieb = __builtin_amdgcn_rcpf(eb);
                const float zq = bf2f(zrow[(size_t)t * NIN + ZQ]);
                const float q = zq * __builtin_amdgcn_rcpf(1.f + __expf(-zq));
                const float ktv = k * ieb; ke[t] = ktv;
                *(LAS bf16_t*)(lds + OFF_QT + (c * 32 + t) * HROWB + d * 2) = (bf16_t)(pk2(q * eb, 0.f) & 0xffffu);
                *(LAS bf16_t*)(lds + OFF_KT + (c * 32 + t) * HROWB + d * 2) = (bf16_t)(pk2(ktv, 0.f) & 0xffffu);
            }
            DEC[c * 128 + d] = eb;
#pragma unroll
            for (int t = 0; t < 32; ++t) ke[t] *= eb;
        } else {
            float sp = 1.f;
#pragma unroll
            for (int t = 31; t >= 0; --t) {
                float zf = bf2f(zrow[(size_t)t * NIN + ZF]); zf = fminf(fmaxf(zf, -30.f), 30.f);
                const float e = __expf(-zf), sg = __builtin_amdgcn_rcpf(1.f + e);
                const float f = lbv + oml * sg, k = oml * e * sg;
                ke[t] = k * sp; sp *= f;
            }
            DEC[c * 128 + d] = sp;
        }
#pragma unroll
        for (int t8 = 0; t8 < 4; ++t8) {
            u32x4 w; w.x = pk2(ke[8 * t8 + 0], ke[8 * t8 + 1]); w.y = pk2(ke[8 * t8 + 2], ke[8 * t8 + 3]); w.z = pk2(ke[8 * t8 + 4], ke[8 * t8 + 5]); w.w = pk2(ke[8 * t8 + 6], ke[8 * t8 + 7]);
            *(LAS u32x4*)(lds + OFF_KET + d * HROWB + (c * 32 + 8 * t8) * 2) = w;
        }
#pragma unroll
        for (int t8 = 0; t8 < 4; ++t8) {
            unsigned v[8];
#pragma unroll
            for (int j = 0; j < 8; ++j) v[j] = zrow[(size_t)(8 * t8 + j) * NIN + ZI];
            u32x4 w; w.x = v[0] | (v[1] << 16); w.y = v[2] | (v[3] << 16); w.z = v[4] | (v[5] << 16); w.w = v[6] | (v[7] << 16);
            *(LAS u32x4*)(lds + OFF_VT + d * HROWB + (c * 32 + 8 * t8) * 2) = w;
        }
    }
    __syncthreads();
    if (!FULL) {
#pragma unroll 1
        for (int c = 0; c < 4; ++c) {
#pragma unroll
            for (int ii = 0; ii < 2; ++ii) {
                const int i = 2 * dh + ii;
#pragma unroll
                for (int g4 = 0; g4 < 4; ++g4) { const f32x4 dv = *(const LAS f32x4*)(DEC + c * 128 + 32 * i + 8 * g4 + 4 * hi);
#pragma unroll
                    for (int j = 0; j < 4; ++j) S[ii][4 * g4 + j] *= dv[j]; }
#pragma unroll
                for (int k2 = 0; k2 < 2; ++k2) {
                    const bf16x8 a = *(const LAS bf16x8*)(lds + OFF_KET + (32 * i + r32) * HROWB + (c * 32 + 16 * k2 + 8 * hi) * 2);
                    const bf16x8 bv = *(const LAS bf16x8*)(lds + OFF_VT + (vb * 32 + r32) * HROWB + (c * 32 + 16 * k2 + 8 * hi) * 2);
                    S[ii] = MFMA32(a, bv, S[ii]);
                }
            }
        }
#pragma unroll
        for (int ii = 0; ii < 2; ++ii)
#pragma unroll
            for (int r = 0; r < 16; ++r) HSu[(32 * (2 * dh + ii) + crow(r, hi)) * 128 + vb * 32 + r32] = S[ii][r];
        if (tid < 128) P.DSC[unit * 128 + tid] = (DEC[tid] * DEC[128 + tid]) * (DEC[256 + tid] * DEC[384 + tid]);
        __syncthreads();
        return;
    }
    if (!act) {
        const int c = wid - 4;
        f32x16 a0, a1;
#pragma unroll
        for (int r = 0; r < 16; ++r) { a0[r] = 0.f; a1[r] = 0.f; }
#pragma unroll
        for (int ks = 0; ks < 8; ks += 2) {
            const bf16x8 ka = *(const LAS bf16x8*)(lds + OFF_KT + (c * 32 + r32) * HROWB + (ks * 16 + 8 * hi) * 2);
            const bf16x8 qa = *(const LAS bf16x8*)(lds + OFF_QT + (c * 32 + r32) * HROWB + (ks * 16 + 8 * hi) * 2);
            const bf16x8 kb = *(const LAS bf16x8*)(lds + OFF_KT + (c * 32 + r32) * HROWB + (ks * 16 + 16 + 8 * hi) * 2);
            const bf16x8 qb = *(const LAS bf16x8*)(lds + OFF_QT + (c * 32 + r32) * HROWB + (ks * 16 + 16 + 8 * hi) * 2);
            a0 = MFMA32(ka, qa, a0); a1 = MFMA32(kb, qb, a1);
        }
#pragma unroll
        for (int r = 0; r < 16; ++r) a0[r] = (crow(r, hi) > r32) ? 0.f : (a0[r] + a1[r]);
#pragma unroll
        for (int s2 = 0; s2 < 2; ++s2) *(LAS bf16x8*)(lds + OFF_AT + ((c * 2 + s2) * 64 + lane) * 16) = packs(a0, s2);
    }
    __syncthreads();
    f32x16 o[4];
    if (act) {
#pragma unroll
        for (int c = 0; c < 4; ++c) {
            f32x16 oa, ob;
#pragma unroll
            for (int r = 0; r < 16; ++r) { oa[r] = 0.f; ob[r] = 0.f; }
#pragma unroll
            for (int s2 = 0; s2 < 2; ++s2) {
                const bf16x8 pa = *(const LAS bf16x8*)(lds + OFF_AT + ((c * 2 + s2) * 64 + lane) * 16);
                const LAS unsigned char* vp = lds + OFF_VT + (vb * 32 + r32) * HROWB + (c * 32 + 16 * s2 + 4 * hi) * 2;
                const bf16x8 av = cat4(*(const LAS s16x4*)vp, *(const LAS s16x4*)(vp + 16));
                oa = MFMA32(av, pa, oa);
            }
#pragma unroll
            for (int i = 0; i < 4; ++i)
#pragma unroll
                for (int s2 = 0; s2 < 2; ++s2) {
                    const bf16x8 sa = packs(S[i], s2);
                    const LAS unsigned char* qp = lds + OFF_QT + (c * 32 + r32) * HROWB + (32 * i + 16 * s2 + 4 * hi) * 2;
                    const bf16x8 bq = cat4(*(const LAS s16x4*)qp, *(const LAS s16x4*)(qp + 16));
                    if (i < 2) ob = MFMA32(sa, bq, ob); else oa = MFMA32(sa, bq, oa);
                }
#pragma unroll
            for (int i = 0; i < 4; ++i) {
#pragma unroll
                for (int g4 = 0; g4 < 4; ++g4) { const f32x4 dv = *(const LAS f32x4*)(DEC + c * 128 + 32 * i + 8 * g4 + 4 * hi);
#pragma unroll
                    for (int j = 0; j < 4; ++j) S[i][4 * g4 + j] *= dv[j]; }
#pragma unroll
                for (int k2 = 0; k2 < 2; ++k2) {
                    const bf16x8 a = *(const LAS bf16x8*)(lds + OFF_KET + (32 * i + r32) * HROWB + (c * 32 + 16 * k2 + 8 * hi) * 2);
                    const bf16x8 bv = *(const LAS bf16x8*)(lds + OFF_VT + (vb * 32 + r32) * HROWB + (c * 32 + 16 * k2 + 8 * hi) * 2);
                    S[i] = MFMA32(a, bv, S[i]);
                }
            }
            float ss = 0.f;
#pragma unroll
            for (int r = 0; r < 16; ++r) { o[c][r] = oa[r] + ob[r]; ss += o[c][r] * o[c][r]; }
            ss += __shfl_xor(ss, 32);
            if (hi == 0) SSb[(c * 4 + wid) * 32 + r32] = ss;
        }
    }
    u32x2 zgv[4][4];
    if (act) {
#pragma unroll
        for (int c = 0; c < 4; ++c)
#pragma unroll
            for (int g4 = 0; g4 < 4; ++g4) zgv[c][g4] = *(const u32x2*)(P.Z + (row0 + c * 32 + r32) * NIN + ZG + h * 128 + vb * 32 + 8 * g4 + 4 * hi);
    }
    __syncthreads();
    if (act) {
#pragma unroll
        for (int c = 0; c < 4; ++c) {
            const float tot = (SSb[(c * 4 + 0) * 32 + r32] + SSb[(c * 4 + 1) * 32 + r32]) + (SSb[(c * 4 + 2) * 32 + r32] + SSb[(c * 4 + 3) * 32 + r32]);
            const float rstd = rsqrtf(tot * (1.f / 128.f) + EPS);
            const size_t row = row0 + c * 32 + r32;
#pragma unroll
            for (int g4 = 0; g4 < 4; ++g4) {
                const int v0 = vb * 32 + 8 * g4 + 4 * hi;
                const u32x2 zg = zgv[c][g4];
                const f32x4 gn = *(const f32x4*)(P.hg_norm + v0);
                float gz[4] = {bflo(zg.x), bfhi(zg.x), bflo(zg.y), bfhi(zg.y)}; float ov[4];
#pragma unroll
                for (int j = 0; j < 4; ++j) ov[j] = o[c][4 * g4 + j] * rstd * gn[j] * (gz[j] * __builtin_amdgcn_rcpf(1.f + __expf(-gz[j])));
                u32x2 w; w.x = pk2(ov[0], ov[1]); w.y = pk2(ov[2], ov[3]);
                *(u32x2*)(P.MIX + row * DM + h * 128 + v0) = w;
            }
        }
    }
    __syncthreads();
}

template <class MaskF>
DI void swa_tile(const LAS unsigned char* KSb, int kstrideB, const LAS unsigned char* VTb, int vstrideB, const bf16x8 (&qf)[4], float sink, MaskF valid, bf16_t* orow, int r32, int hi) {
    f32x16 st[5];
#pragma unroll
    for (int kt = 0; kt < 5; ++kt) {
#pragma unroll
        for (int r = 0; r < 16; ++r) st[kt][r] = 0.f;
#pragma unroll
        for (int ks = 0; ks < 4; ++ks) { const bf16x8 a = *(const LAS bf16x8*)(KSb + (32 * kt + r32) * kstrideB + (16 * ks + 8 * hi) * 2); st[kt] = MFMA32(a, qf[ks], st[kt]); }
    }
    float m = sink;
#pragma unroll
    for (int kt = 0; kt < 5; ++kt)
#pragma unroll
        for (int r = 0; r < 16; ++r) { const int jr = 32 * kt + crow(r, hi); const float s = valid(jr) ? st[kt][r] * 0.125f : -INFINITY; st[kt][r] = s; m = fmaxf(m, s); }
    m = fmaxf(m, __shfl_xor(m, 32));
    float den = 0.f;
#pragma unroll
    for (int kt = 0; kt < 5; ++kt)
#pragma unroll
        for (int r = 0; r < 16; ++r) { const float p = __expf(st[kt][r] - m); st[kt][r] = p; den += p; }
    den += __shfl_xor(den, 32);
    den += __expf(sink - m);
    f32x16 o[2];
#pragma unroll
    for (int r = 0; r < 16; ++r) { o[0][r] = 0.f; o[1][r] = 0.f; }
#pragma unroll
    for (int kt = 0; kt < 5; ++kt)
#pragma unroll
        for (int s2 = 0; s2 < 2; ++s2) {
            const bf16x8 pb = packs(st[kt], s2);
#pragma unroll
            for (int dt = 0; dt < 2; ++dt) {
                const LAS unsigned char* vp = VTb + (32 * dt + r32) * vstrideB + (32 * kt + 16 * s2 + 4 * hi) * 2;
                const bf16x8 av = cat4(*(const LAS s16x4*)vp, *(const LAS s16x4*)(vp + 16));
                o[dt] = MFMA32(av, pb, o[dt]);
            }
        }
    const float inv = 1.f / den;
#pragma unroll
    for (int dt = 0; dt < 2; ++dt)
#pragma unroll
        for (int g4 = 0; g4 < 4; ++g4) { const int d0 = 32 * dt + 8 * g4 + 4 * hi;
            u32x2 w; w.x = pk2(o[dt][4 * g4] * inv, o[dt][4 * g4 + 1] * inv); w.y = pk2(o[dt][4 * g4 + 2] * inv, o[dt][4 * g4 + 3] * inv);
            *(u32x2*)(orow + d0) = w; }
}

constexpr int PK_STRB = 144, PV_STRB = 528, P_OFF_V = 256 * PK_STRB;
DI void swa_prompt_unit(LAS unsigned char* lds, const Ptrs& P, int unit) {
    const int tid = threadIdx.x, lane = tid & 63, wid = __builtin_amdgcn_readfirstlane(tid >> 6), r32 = lane & 31, hi = lane >> 5;
    const int kvh = unit & 1, n = (unit >> 1) & 31, b = unit >> 6;
    const long rowk0 = (long)b * SEQ + (long)(n - 1) * 128;
    const int g = wid >> 1, half = wid & 1, qh = kvh * 4 + g;
    bf16x8 qf[2][4];
#pragma unroll
    for (int sub = 0; sub < 2; ++sub)
#pragma unroll
        for (int ks = 0; ks < 4; ++ks) qf[sub][ks] = *(const bf16x8*)(P.Z + ((size_t)b * SEQ + n * 128 + 64 * half + 32 * sub + r32) * NIN + ZSQ + qh * 64 + 16 * ks + 8 * hi);
#pragma unroll
    for (int i = 0; i < 4; ++i) {
        const int q = tid + 512 * i, j = q >> 3, part = q & 7;
        u32x4 kv = (u32x4){0u, 0u, 0u, 0u}, vv = (u32x4){0u, 0u, 0u, 0u};
        if (n > 0 || j >= 128) { const bf16_t* zr = P.Z + (size_t)(rowk0 + j) * NIN + kvh * 64 + part * 8; kv = *(const u32x4*)(zr + ZSK); vv = *(const u32x4*)(zr + ZSV); }
        *(LAS u32x4*)(lds + j * PK_STRB + part * 16) = kv;
        LAS bf16_t* vt = (LAS bf16_t*)(lds + P_OFF_V + (part * 8) * PV_STRB + j * 2);
        const unsigned vw[4] = {vv.x, vv.y, vv.z, vv.w};
#pragma unroll
        for (int e = 0; e < 4; ++e) { vt[(2 * e) * (PV_STRB / 2)] = (bf16_t)(vw[e] & 0xffffu); vt[(2 * e + 1) * (PV_STRB / 2)] = (bf16_t)(vw[e] >> 16); }
    }
    __syncthreads();
    const float sink = P.sinks[qh];
    const int jmin = n == 0 ? 128 : 0;
#pragma unroll
    for (int sub = 0; sub < 2; ++sub) {
        const int i0 = 64 * half + 32 * sub;
        const size_t row = (size_t)b * SEQ + n * 128 + i0 + r32;
        auto valid = [=](int jr) { return (jr > r32) && (jr <= r32 + 128) && (i0 + jr >= jmin); };
        swa_tile(lds + i0 * PK_STRB, PK_STRB, lds + P_OFF_V + i0 * 2, PV_STRB, qf[sub], sink, valid, P.MIX + row * DM + 512 + qh * 64, r32, hi);
    }
    __syncthreads();
}

constexpr int SK_STRB = 144, SV_STRB = 336, S_OFF_V = 2 * 160 * SK_STRB;
static_assert(S_OFF_V + 2 * 64 * SV_STRB <= LDS_BYTES, "swa sample lds");
DI void swa_sample_unit(LAS unsigned char* lds, const Ptrs& P, int b) {
    const int tid = threadIdx.x, lane = tid & 63, wid = __builtin_amdgcn_readfirstlane(tid >> 6), r32 = lane & 31, hi = lane >> 5;
    float* okb = P.out + O_KS + (size_t)b * 16384; float* ovb = P.out + O_VS + (size_t)b * 16384;
#pragma unroll
    for (int i = 0; i < 8; ++i) {
        const int q = tid + 512 * i, j = q >> 5, c4 = q & 31, kvh = c4 >> 4, d0 = (c4 & 15) * 4;
        const f32x4 kf = *(const f32x4*)(P.ck + (size_t)b * 16384 + j * 128 + c4 * 4);
        const f32x4 vf = *(const f32x4*)(P.cv + (size_t)b * 16384 + j * 128 + c4 * 4);
        if (j >= 8) { *(f32x4*)(okb + (j - 8) * 128 + c4 * 4) = kf; *(f32x4*)(ovb + (j - 8) * 128 + c4 * 4) = vf; }
        u32x2 kw; kw.x = pk2(kf[0], kf[1]); kw.y = pk2(kf[2], kf[3]);
        *(LAS u32x2*)(lds + (kvh * 160 + j) * SK_STRB + d0 * 2) = kw;
        const unsigned v01 = pk2(vf[0], vf[1]), v23 = pk2(vf[2], vf[3]);
        LAS bf16_t* vt = (LAS bf16_t*)(lds + S_OFF_V + (kvh * 64 + d0) * SV_STRB + j * 2);
        vt[0] = (bf16_t)(v01 & 0xffffu); vt[SV_STRB / 2] = (bf16_t)(v01 >> 16); vt[2 * (SV_STRB / 2)] = (bf16_t)(v23 & 0xffffu); vt[3 * (SV_STRB / 2)] = (bf16_t)(v23 >> 16);
    }
    for (int e = tid; e < 2048; e += 512) {
        const int isv = e >> 10, s = (e >> 7) & 7, c = e & 127, kvh = c >> 6, d = c & 63;
        const bf16_t raw = P.Z[(size_t)(NTP + b * 8 + s) * NIN + (isv ? ZSV : ZSK) + c];
        (isv ? ovb : okb)[(120 + s) * 128 + c] = bf2f(raw);
        if (isv) *(LAS bf16_t*)(lds + S_OFF_V + (kvh * 64 + d) * SV_STRB + (128 + s) * 2) = raw;
        else *(LAS bf16_t*)(lds + (kvh * 160 + 128 + s) * SK_STRB + d * 2) = raw;
    }
    for (int e = tid; e < 2 * 24 * 64; e += 512) {
        const int kvh = e / 1536, rem = e % 1536, jj = rem >> 6, d = rem & 63;
        *(LAS bf16_t*)(lds + (kvh * 160 + 136 + jj) * SK_STRB + d * 2) = 0;
        *(LAS bf16_t*)(lds + S_OFF_V + (kvh * 64 + d) * SV_STRB + (136 + jj) * 2) = 0;
    }
    __syncthreads();
    if (wid < 2) {
        const int kvh = wid, g = r32 >> 3, s = r32 & 7, qh = kvh * 4 + g;
        const size_t row = (size_t)NTP + b * 8 + s;
        auto valid = [=](int jr) { return jr < 128 ? (jr > s) : (jr - 128 <= s); };
        bf16x8 qf[4];
#pragma unroll
        for (int ks = 0; ks < 4; ++ks) qf[ks] = *(const bf16x8*)(P.Z + row * NIN + ZSQ + qh * 64 + 16 * ks + 8 * hi);
        swa_tile(lds + kvh * 160 * SK_STRB, SK_STRB, lds + S_OFF_V + kvh * 64 * SV_STRB, SV_STRB, qf, P.sinks[qh], valid, P.MIX + row * DM + 512 + qh * 64, r32, hi);
    }
    __syncthreads();
}

DI void hgrn_sample_unit(LAS unsigned char* lds, const Ptrs& P, int unit) {
    const int tid = threadIdx.x, lane = tid & 63, wid = __builtin_amdgcn_readfirstlane(tid >> 6), hi = lane >> 5;
    const int b = unit >> 2, h = unit & 3;
    const int dg = tid >> 5, vq = tid & 31;
    const size_t soff = ((size_t)unit * 128 + dg * 8) * 128 + vq * 4;
    f32x4 S[8];
#pragma unroll
    for (int i = 0; i < 8; ++i) S[i] = *(const f32x4*)(P.state + soff + i * 128);
    LAS float* Fs = (LAS float*)lds; LAS float* Ks = Fs + 1024; LAS float* Qs = Ks + 1024; LAS float* Vs = Qs + 1024; LAS float* Gs = Vs + 1024; LAS float* OP = Gs + 1024;
    for (int e = tid; e < 1024; e += 512) {
        const int t = e >> 7, d = e & 127;
        const bf16_t* zr = P.Z + (size_t)(NTP + b * 8 + t) * NIN + h * 128 + d;
        const float zq = bf2f(zr[ZQ]), zi = bf2f(zr[ZI]), zg = bf2f(zr[ZG]); float zf = bf2f(zr[ZF]); zf = fminf(fmaxf(zf, -30.f), 30.f);
        const float l0 = P.lb_logits[h * 128 + d], l1 = P.lb_logits[512 + h * 128 + d];
        const float lbv = 1.f / (1.f + __expf(l1 - l0)), oml = 1.f - lbv;
        const float ex = __expf(-zf), sg = 1.f / (1.f + ex);
        Fs[e] = lbv + oml * sg; Ks[e] = oml * ex * sg; Qs[e] = zq / (1.f + __expf(-zq)); Vs[e] = zi; Gs[e] = zg / (1.f + __expf(-zg));
    }
    __syncthreads();
#pragma unroll 1
    for (int t = 0; t < 8; ++t) {
        const f32x4 v = *(const LAS f32x4*)(Vs + t * 128 + vq * 4); f32x4 op = (f32x4){0.f, 0.f, 0.f, 0.f};
#pragma unroll
        for (int i = 0; i < 8; ++i) { const int d = dg * 8 + i; const float f = Fs[t * 128 + d], k = Ks[t * 128 + d], q = Qs[t * 128 + d];
            S[i] = S[i] * f + v * k; op += S[i] * q; }
#pragma unroll
        for (int j = 0; j < 4; ++j) op[j] += __shfl_xor(op[j], 32);
        if (hi == 0) *(LAS f32x4*)(OP + (t * 8 + wid) * 128 + vq * 4) = op;
    }
    float* so = P.out + O_SS + soff;
#pragma unroll
    for (int i = 0; i < 8; ++i) *(f32x4*)(so + i * 128) = S[i];
    __syncthreads();
    {
        const int t = wid; float o0 = 0.f, o1 = 0.f;
#pragma unroll
        for (int w = 0; w < 8; ++w) { o0 += OP[(t * 8 + w) * 128 + lane]; o1 += OP[(t * 8 + w) * 128 + 64 + lane]; }
        const float rstd = rsqrtf(wave_sum(o0 * o0 + o1 * o1) * (1.f / 128.f) + EPS);
        bf16_t* mo = P.MIX + (size_t)(NTP + b * 8 + t) * DM + h * 128;
        mo[lane] = (bf16_t)(pk2(o0 * rstd * P.hg_norm[lane] * Gs[t * 128 + lane], 0.f) & 0xffffu);
        mo[64 + lane] = (bf16_t)(pk2(o1 * rstd * P.hg_norm[64 + lane] * Gs[t * 128 + 64 + lane], 0.f) & 0xffffu);
    }
    __syncthreads();
}

DI void scan_phase(const Ptrs& P, int G, int skip) {
    if ((int)blockIdx.x < skip) return;
    const int gt = ((int)blockIdx.x - skip) * 512 + threadIdx.x, NT = (G - skip) * 512;
    for (int idx4 = gt; idx4 < 32 * 4096; idx4 += NT) {
        const int bh = idx4 >> 12, e = (idx4 & 4095) * 4, d = e >> 7;
        float* hp = P.HS + (size_t)bh * 32 * 16384 + e; const float* dp = P.DSC + bh * 32 * 128 + d;
        f32x4 S = (f32x4){0.f, 0.f, 0.f, 0.f};
#pragma unroll 1
        for (int s0 = 0; s0 < 32; s0 += 8) {
            f32x4 Hv[8]; float dv[8];
#pragma unroll
            for (int j = 0; j < 8; ++j) { Hv[j] = *(const f32x4*)(hp + (size_t)(s0 + j) * 16384); dv[j] = dp[(s0 + j) * 128]; }
#pragma unroll
            for (int j = 0; j < 8; ++j) { *(f32x4*)(hp + (size_t)(s0 + j) * 16384) = S; S = S * dv[j] + Hv[j]; }
        }
        *(f32x4*)(P.out + O_SP + (size_t)bh * 16384 + e) = S;
    }
    for (int e = gt; e < 8 * 128 * 256; e += NT) {
        const int b = e >> 15, j = (e >> 8) & 127, c = e & 255;
        const float v = bf2f(P.Z[(size_t)(b * SEQ + SEQ - 128 + j) * NIN + ZSK + c]);
        if (c < 128) P.out[O_KP + (size_t)(b * 128 + j) * 128 + c] = v; else P.out[O_VP + (size_t)(b * 128 + j) * 128 + (c - 128)] = v;
    }
}

DI void final_norm(const Ptrs& P, int G) {
    const int tid = threadIdx.x, lane = tid & 63, wave = tid >> 6;
    const int gw = blockIdx.x * 8 + wave, NGW = G * 8;
    f32x4 gv[4];
#pragma unroll
    for (int j = 0; j < 4; ++j) gv[j] = *((const f32x4*)P.ln_final + lane + 64 * j);
    for (int m0 = gw; m0 < NTP; m0 += 2 * NGW) {
        const int m1 = m0 + NGW; const bool has1 = m1 < NTP; const int mm1 = has1 ? m1 : m0;
        f32x4* y0 = (f32x4*)(P.out + (size_t)m0 * DM) + lane; f32x4* y1 = (f32x4*)(P.out + (size_t)mm1 * DM) + lane;
        f32x4 v0[4], v1[4]; float s0 = 0.f, s1 = 0.f;
#pragma unroll
        for (int j = 0; j < 4; ++j) { v0[j] = y0[64 * j]; v1[j] = y1[64 * j]; }
#pragma unroll
        for (int j = 0; j < 4; ++j) { s0 += (v0[j].x * v0[j].x + v0[j].y * v0[j].y) + (v0[j].z * v0[j].z + v0[j].w * v0[j].w); s1 += (v1[j].x * v1[j].x + v1[j].y * v1[j].y) + (v1[j].z * v1[j].z + v1[j].w * v1[j].w); }
        const float r0 = rsqrtf(wave_sum(s0) * (1.f / DM) + EPS), r1 = rsqrtf(wave_sum(s1) * (1.f / DM) + EPS);
#pragma unroll
        for (int j = 0; j < 4; ++j) y0[64 * j] = v0[j] * r0 * gv[j];
        if (has1) {
#pragma unroll
            for (int j = 0; j < 4; ++j) y1[64 * j] = v1[j] * r1 * gv[j];
        }
    }
    for (int m = NTP + gw; m < M; m += NGW) {
        f32x4* yr = (f32x4*)(P.out + (size_t)m * DM) + lane;
        f32x4 v[4]; float s = 0.f;
#pragma unroll
        for (int j = 0; j < 4; ++j) v[j] = yr[64 * j];
#pragma unroll 4
        for (int sl = 0; sl < 16; ++sl) { const f32x4* pr = (const f32x4*)(P.PART + ((size_t)sl * NTS + (m - NTP)) * DM) + lane;
#pragma unroll
            for (int j = 0; j < 4; ++j) v[j] += pr[64 * j]; }
#pragma unroll
        for (int j = 0; j < 4; ++j) s += (v[j].x * v[j].x + v[j].y * v[j].y) + (v[j].z * v[j].z + v[j].w * v[j].w);
        const float rstd = rsqrtf(wave_sum(s) * (1.f / DM) + EPS);
#pragma unroll
        for (int j = 0; j < 4; ++j) yr[64 * j] = v[j] * rstd * gv[j];
    }
}

#define XB_TMO      128
#define XB_XCNT(j)  (256  + 64 * (j))
#define XB_XSUB(j)  (1280 + 64 * (j))
#define XB_XGEN(j)  (2304 + 64 * (j))
#define XB_TOP      3328
#define XB_TOPGEN   3392
#define XCD_BAR_WORDS 3456
#define XB_SPIN_CAP (1u << 18)
DI unsigned xb_ld(unsigned* p)              { return __hip_atomic_load(p, __ATOMIC_RELAXED, __HIP_MEMORY_SCOPE_AGENT); }
DI unsigned xb_add(unsigned* p, unsigned v) { return __hip_atomic_fetch_add(p, v, __ATOMIC_RELAXED, __HIP_MEMORY_SCOPE_AGENT); }
DI unsigned xb_xcc_id() { return (unsigned)__builtin_amdgcn_s_getreg((3 << 11) | 20) & 0xFu; }
#define XB_SPIN(cond, bar) do { unsigned _sp = 0; while (cond) { __builtin_amdgcn_s_sleep(1); \
    if ((++_sp & 255u) == 0u) { if (xb_ld(&(bar)[XB_TMO])) break; if (_sp > XB_SPIN_CAP) { atomicAdd(&(bar)[XB_TMO], 1u); break; } } } } while (0)
struct XcdBarrier { unsigned* bar; unsigned x; volatile LAS unsigned* st; };
DI XcdBarrier xcd_barrier_post(unsigned* bar, volatile LAS unsigned* st) {
    XcdBarrier b; b.bar = bar; b.x = xb_xcc_id(); b.st = st;
    if (threadIdx.x == 0) (void)xb_add(&bar[XB_XCNT(b.x)], 1u);
    return b;
}
DI void xcd_barrier_complete(unsigned* bar, unsigned x, unsigned& nloc, unsigned& nx) {
    const unsigned G = gridDim.x * gridDim.y * gridDim.z;
    unsigned sum, cnt, mine, sp = 0u;
    for (;;) {
        sum = 0u; cnt = 0u; mine = 0u;
#pragma unroll
        for (unsigned j = 0; j < 16; ++j) { const unsigned c = xb_ld(&bar[XB_XCNT(j)]); sum += c; cnt += (c > 0u) ? 1u : 0u; mine = (j == x) ? c : mine; }
        if (sum == G) break;
        __builtin_amdgcn_s_sleep(1);
        if ((++sp & 255u) == 0u) { if (xb_ld(&bar[XB_TMO])) break; if (sp > XB_SPIN_CAP) { atomicAdd(&bar[XB_TMO], 1u); break; } }
    }
    nloc = mine > 0u ? mine : 1u; nx = cnt > 0u ? cnt : 1u;
}
DI void xcd_barrier(const XcdBarrier& b) {
    asm volatile("s_waitcnt vmcnt(0)" ::: "memory");
    __syncthreads();
    if (threadIdx.x == 0) {
        unsigned* bar = b.bar;
        __builtin_amdgcn_s_waitcnt(0);
        unsigned nloc = b.st[0], nx = b.st[1];
        if (nloc == 0u) { xcd_barrier_complete(bar, b.x, nloc, nx); b.st[0] = nloc; b.st[1] = nx; }
        const unsigned old = xb_add(&bar[XB_XSUB(b.x)], 1u);
        const unsigned gen = old / nloc;
        if (old + 1u == (gen + 1u) * nloc) {
            __builtin_amdgcn_fence(__ATOMIC_RELEASE, "agent");
            asm volatile("s_waitcnt vmcnt(0)" ::: "memory");
            const unsigned og = xb_add(&bar[XB_TOP], 1u);
            const unsigned tg = og / nx;
            if (og + 1u == (tg + 1u) * nx) xb_add(&bar[XB_TOPGEN], 1u);
            else XB_SPIN(xb_ld(&bar[XB_TOPGEN]) == tg, bar);
            __builtin_amdgcn_fence(__ATOMIC_ACQUIRE, "agent");
            xb_add(&bar[XB_XGEN(b.x)], 1u);
            asm volatile("s_waitcnt vmcnt(0)" ::: "memory");
        } else {
            XB_SPIN(xb_ld(&bar[XB_XGEN(b.x)]) == gen, bar);
            __builtin_amdgcn_fence(__ATOMIC_ACQUIRE, "agent");
            asm volatile("s_waitcnt vmcnt(0)" ::: "memory");
        }
    }
    __syncthreads();
}

struct Args { const float* in[15]; float* out; unsigned char* ws; int ph_lo, ph_hi; };
constexpr int NPHASE = 9;

__global__ void __launch_bounds__(512, 2) mk_fwd(Args args) {
    extern __shared__ __attribute__((aligned(16))) unsigned char lds_raw[];
    LAS unsigned char* lds = (LAS unsigned char*)lds_raw;
    cg::grid_group grid = cg::this_grid();
    const int G = gridDim.x;
    Ptrs P;
    P.x_p = args.in[0]; P.x_s = args.in[1]; P.state = args.in[2]; P.ck = args.in[3]; P.cv = args.in[4]; P.ln_mix = args.in[5]; P.w_in = args.in[6]; P.lb_logits = args.in[7];
    P.hg_norm = args.in[8]; P.sinks = args.in[9]; P.w_out = args.in[10]; P.ln_mlp = args.in[11]; P.w_up = args.in[12]; P.w_down = args.in[13]; P.ln_final = args.in[14];
    P.out = args.out;
    unsigned char* ws = args.ws;
    P.WinT = (bf16_t*)(ws + WS_WIN); P.WoutT = (bf16_t*)(ws + WS_WOUT); P.WupT = (bf16_t*)(ws + WS_WUP); P.WdnT = (bf16_t*)(ws + WS_WDN);
    P.XN = (bf16_t*)(ws + WS_XN); P.Z = (bf16_t*)(ws + WS_Z); P.MIX = (bf16_t*)(ws + WS_MIX); P.U = (bf16_t*)(ws + WS_U);
    P.HS = (float*)(ws + WS_HS); P.DSC = (float*)(ws + WS_DSC); P.rss1 = (float*)(ws + WS_RSS1); P.rss2 = (float*)(ws + WS_RSS2); P.PART = (float*)(ws + WS_PART);
    const int lo = args.ph_lo, hi = args.ph_hi;
    unsigned* barw = (unsigned*)(ws + WS_BAR);
    volatile LAS unsigned* misc = (volatile LAS unsigned*)(lds + LDS_MISC);
    if (threadIdx.x < 2) misc[threadIdx.x] = 0u;
    __syncthreads();
    if (hi < 0) grid.sync();
    XcdBarrier xbar = xcd_barrier_post(barw, misc);
#define IN(k) (lo <= (k) && (k) < hi)
#define SEAM(k) do { if (IN(k) && IN((k) + 1)) xcd_barrier(xbar); } while (0)
    if (IN(0)) { p0_prologue(lds, P, G); if (PROBE_P0) { __syncthreads(); p0_prologue(lds, P, G); } }
    SEAM(0);
    if (PROBE_SYNC) { for (int i = 0; i < 8; ++i) grid.sync(); }
    if (IN(1)) { pg8::Gemm g{P.XN, P.WinT, DM, DM / 64}; pg8::StaticOrder S; S.init(M, NIN, G, (int)blockIdx.x); pg8::EpiZ E{P.Z, NIN};
        pg8::gemm_phase<pg8::EpiZ, pg8::StaticOrder, true>(lds, g, S, E); }
    SEAM(1);
    if (IN(2)) {
        for (int rep = 0; rep < 1 + PROBE_P2A; ++rep)
        for (int u = blockIdx.x; u < 1024; u += G) hgrn_unit<false>(lds, P, u);
        for (int rep = 0; rep < 1 + PROBE_P2A; ++rep) {
        for (int u = blockIdx.x; u < 512; u += G) swa_prompt_unit(lds, P, u);
        for (int u = blockIdx.x; u < 512; u += G) hgrn_sample_unit(lds, P, u);
        for (int u = blockIdx.x; u < 128; u += G) swa_sample_unit(lds, P, u); }
    }
    SEAM(2);
    if (IN(3)) {
        { pg8::Gemm g{P.MIX, P.WoutT, DM, DM / 64}; pg8::RectOrder S; S.init(NTP / 256, NTS / 256, DM / 256, 1, DM / 64, G, (int)blockIdx.x); pg8::EpiRes1 E{P.x_p, P.x_s, P.out, P.XN, P.rss1};
          pg8::gemm_phase<pg8::EpiRes1, pg8::RectOrder, true>(lds, g, S, E); }
        scan_phase(P, G, G > 32 ? 16 : 0);
    }
    SEAM(3);
    if (IN(4)) { for (int rep = 0; rep < 1 + PROBE_P2C; ++rep) for (int u = blockIdx.x; u < 1024; u += G) hgrn_unit<true>(lds, P, u); }
    SEAM(4);
    if (IN(5)) {
        { pg8::Gemm g{P.MIX, P.WoutT, DM, DM / 64}; pg8::StaticOrder S; S.init(NTP, DM, G, (int)blockIdx.x); pg8::EpiRes1 E{P.x_p, P.x_s, P.out, P.XN, P.rss1};
          pg8::gemm_phase<pg8::EpiRes1, pg8::StaticOrder, true>(lds, g, S, E); }
        { pg8::Gemm g{P.XN, P.WupT, DM, DM / 64}; pg8::RectOrder S; S.init(NTP / 256, NTS / 256, FF / 256, 1, DM / 64, G, (int)blockIdx.x); pg8::EpiUp E{P.U, FF, P.rss1};
          pg8::gemm_phase<pg8::EpiUp, pg8::RectOrder, true>(lds, g, S, E); }
    }
    SEAM(5);
    if (IN(6)) {
        { pg8::Gemm g{P.XN, P.WupT, DM, DM / 64}; pg8::StaticOrder S; S.init(NTP, FF, G, (int)blockIdx.x); pg8::EpiUp E{P.U, FF, P.rss1};
          pg8::gemm_phase<pg8::EpiUp, pg8::StaticOrder, true>(lds, g, S, E); }
        { pg8::Gemm g{P.U, P.WdnT, FF, 4}; pg8::RectOrder S; S.init(NTP / 256, NTS / 256, DM / 256, 16, 4, G, (int)blockIdx.x); pg8::EpiDown<true> E{P.out, P.PART};
          pg8::gemm_phase<pg8::EpiDown<true>, pg8::RectOrder, true, true>(lds, g, S, E); }
    }
    SEAM(6);
    if (IN(7)) { pg8::Gemm g{P.U, P.WdnT, FF, FF / 64}; pg8::StaticOrder S; S.init(NTP, DM, G, (int)blockIdx.x); pg8::EpiDown<false> E{P.out, nullptr};
        pg8::gemm_phase<pg8::EpiDown<false>, pg8::StaticOrder, true>(lds, g, S, E); }
    SEAM(7);
    if (IN(8)) { final_norm(P, G); }
#undef IN
#undef SEAM
}

extern "C" void kernel_launch(void* const* d_in, const int* in_sizes, int n_in, void* d_out, int out_size, void* d_ws, size_t ws_size, hipStream_t stream) {
    static int grid = 0;
    if (grid == 0) {
        if (n_in != 15 || (size_t)out_size != O_END || ws_size < WS_END) { fprintf(stderr, "kernel_launch: unexpected shapes (n_in %d out %d ws %zu)\n", n_in, out_size, ws_size); grid = -1; return; }
        int dev = 0, cus = 0, per_cu = 0;
        (void)hipGetDevice(&dev); (void)hipDeviceGetAttribute(&cus, hipDeviceAttributeMultiprocessorCount, dev);
        if (hipFuncSetAttribute((const void*)mk_fwd, hipFuncAttributeMaxDynamicSharedMemorySize, LDS_BYTES) != hipSuccess) { fprintf(stderr, "kernel_launch: hipFuncSetAttribute failed\n"); grid = -1; return; }
        if (hipOccupancyMaxActiveBlocksPerMultiprocessor(&per_cu, (const void*)mk_fwd, 512, LDS_BYTES) != hipSuccess || per_cu < 1) { fprintf(stderr, "kernel_launch: occupancy query says %d\n", per_cu); per_cu = 1; }
        (void)hipGetLastError();
        if (per_cu > 1) per_cu = 1;
        grid = cus * per_cu;
    }
    if (grid < 0) return;
    if (hipMemsetAsync((char*)d_ws + WS_BAR, 0, 16384, stream) != hipSuccess) { fprintf(stderr, "kernel_launch: memset of the barrier words failed\n"); return; }
    Args a{};
    for (int i = 0; i < 15; ++i) a.in[i] = (const float*)d_in[i];
    a.out = (float*)d_out; a.ws = (unsigned char*)d_ws;
#if MK_COOP
    a.ph_lo = 0; a.ph_hi = NPHASE;
    void* kargs[] = {&a};
    hipError_t e = hipLaunchCooperativeKernel((const void*)mk_fwd, dim3(grid), dim3(512), kargs, LDS_BYTES, stream);
    if (e != hipSuccess) fprintf(stderr, "cooperative launch failed: %s (grid %d)\n", hipGetErrorString(e), grid);
#else
    for (int p = 0; p < NPHASE; ++p) { a.ph_lo = p; a.ph_hi = p + 1; hipLaunchKernelGGL(mk_fwd, dim3(grid), dim3(512), LDS_BYTES, stream, a); }
#endif
}
```

```cpp
#include <hip/hip_runtime.h>
#include <hip/hip_cooperative_groups.h>
#include <cstdio>
#include <cstdint>
namespace cg = cooperative_groups;

#ifndef MK_COOP
#define MK_COOP 1
#endif
#define PROBE_P0 0
#define PROBE_P2A 0
#define PROBE_P2C 0
#define PROBE_SYNC 0

#define DI __device__ __forceinline__
#define LAS __attribute__((address_space(3)))
typedef unsigned short bf16_t;
typedef short bf16x8 __attribute__((ext_vector_type(8)));
typedef short s16x4 __attribute__((ext_vector_type(4)));
typedef float f32x4 __attribute__((ext_vector_type(4)));
typedef float f32x16 __attribute__((ext_vector_type(16)));
typedef unsigned u32x4 __attribute__((ext_vector_type(4)));
typedef unsigned u32x2 __attribute__((ext_vector_type(2)));
typedef float f32x2_t __attribute__((ext_vector_type(2)));
typedef __bf16 bf16x2_t __attribute__((ext_vector_type(2)));

DI unsigned pk2(float lo, float hi) { f32x2_t v = {lo, hi}; bf16x2_t b = __builtin_convertvector(v, bf16x2_t); return __builtin_bit_cast(unsigned, b); }
DI float bf2f(bf16_t v) { return __uint_as_float(((unsigned)v) << 16); }
DI float bflo(unsigned w) { return __uint_as_float(w << 16); }
DI float bfhi(unsigned w) { return __uint_as_float(w & 0xffff0000u); }
DI int crow(int reg, int h) { return (reg & 3) + 8 * (reg >> 2) + 4 * h; }
#define MFMA32(a, b, c) __builtin_amdgcn_mfma_f32_32x32x16_bf16((a), (b), (c), 0, 0, 0)
DI bf16x8 packs(const f32x16& x, int s) {
    u32x4 p; p.x = pk2(x[8 * s], x[8 * s + 1]); p.y = pk2(x[8 * s + 2], x[8 * s + 3]); p.z = pk2(x[8 * s + 4], x[8 * s + 5]); p.w = pk2(x[8 * s + 6], x[8 * s + 7]);
    return __builtin_bit_cast(bf16x8, p);
}
DI bf16x8 cat4(s16x4 lo, s16x4 hi) { return __builtin_shufflevector(lo, hi, 0, 1, 2, 3, 4, 5, 6, 7); }
DI float wave_sum(float v) {
#pragma unroll
    for (int o = 1; o < 64; o <<= 1) v += __shfl_xor(v, o);
    return v;
}

constexpr int DM = 1024, SEQ = 4096, NB = 8, NTP = NB * SEQ, DB = 128, DS = 8, NTS = DB * DS, M = NTP + NTS;
constexpr int NIN = 2816, FF = 4096;
constexpr int ZQ = 0, ZF = 512, ZI = 1024, ZG = 1536, ZSQ = 2048, ZSK = 2560, ZSV = 2688;
constexpr float EPS = 1e-6f;
constexpr size_t O_Y = 0, O_SP = (size_t)M * DM, O_KP = O_SP + 8 * 4 * 128 * 128, O_VP = O_KP + 8 * 128 * 128, O_SS = O_VP + 8 * 128 * 128,
                 O_KS = O_SS + (size_t)128 * 4 * 128 * 128, O_VS = O_KS + (size_t)128 * 128 * 128, O_END = O_VS + (size_t)128 * 128 * 128;
constexpr size_t MiB = 1u << 20;
constexpr size_t WS_RSS1 = 0, WS_RSS2 = 256 * 1024, WS_BAR = 512 * 1024, WS_WIN = 1 * MiB, WS_WOUT = 7 * MiB, WS_WUP = 9 * MiB, WS_WDN = 17 * MiB, WS_DSC = 25 * MiB,
                 WS_XN = 26 * MiB, WS_Z = 92 * MiB, WS_MIX = 274 * MiB, WS_HS = 340 * MiB, WS_U = 92 * MiB, WS_PART = 404 * MiB, WS_END = 468 * MiB;
static_assert(WS_XN + (size_t)M * DM * 2 <= WS_Z && WS_Z + (size_t)M * NIN * 2 <= WS_MIX && WS_MIX + (size_t)M * DM * 2 <= WS_HS && WS_U + (size_t)M * FF * 2 <= WS_END, "ws map");
constexpr int LDS_BYTES = 155648, LDS_MISC = LDS_BYTES - 64;

namespace pg8 {
constexpr int BM = 256, BK = 64, HALF = 128, HTB = HALF * BK * 2, STAGE_BYTES = 8 * HTB, NXCD = 8, WGM = 8;
DI int lds_byte(int r, int c) { const int st = (r >> 4) * 2 + (c >> 5), rr = r & 15, cc = c & 31, ob = rr * 64 + cc * 2; return st * 1024 + (ob ^ (((ob >> 9) & 1) << 5)); }
DI void stage_rc(int b, int& R, int& C) { const int st = b / 1024, sb = b % 1024, swz = sb ^ (((sb >> 9) & 1) << 5); R = (st >> 1) * 16 + swz / 64; C = (st & 1) * 32 + (swz % 64) / 2; }
DI int perm32(int rho) { const int n = rho >> 4, i = rho & 15; return 8 * (i >> 2) + 4 * n + (i & 3); }
struct Unit { int pm, pn, kt0; };
struct Gemm { const bf16_t* A; const bf16_t* Bt; int K, nt; };
struct StaticOrder {
    int nM, nN, nwg, G, c;
    DI void init(int M_, int N_, int G_, int c_) { nM = M_ / BM; nN = N_ / BM; nwg = nM * nN; G = G_; c = c_; }
    DI bool next(int i, Unit& u) const {
        const long L = (long)i * G + c; if (L >= nwg) return false;
        int wgid = (int)L; { const int q = nwg / NXCD, r = nwg % NXCD, xcd = wgid % NXCD, off = wgid / NXCD; wgid = (xcd < r ? xcd * (q + 1) : r * (q + 1) + (xcd - r) * q) + off; }
        const int nig = WGM * nN, gid = wgid / nig, fm = gid * WGM, gsz = (nM - fm) < WGM ? (nM - fm) : WGM;
        u.pm = fm + ((wgid % nig) % gsz); u.pn = (wgid % nig) / gsz; u.kt0 = 0; return true;
    }
};
struct RectOrder {
    int pm0, nN, nslice, nt, total, G, c;
    DI void init(int pm0_, int nPm, int nN_, int nslice_, int nt_, int G_, int c_) { pm0 = pm0_; nN = nN_; nslice = nslice_; nt = nt_; total = nPm * nN_ * nslice_; G = G_; c = c_; }
    DI bool next(int i, Unit& u) const {
        const long L = (long)i * G + c; if (L >= total) return false;
        const int sl = (int)L % nslice, t = (int)L / nslice; u.pn = t % nN; u.pm = pm0 + t / nN; u.kt0 = sl * nt; return true;
    }
};
struct EpiZ {
    static constexpr bool PERM = true;
    bf16_t* O; int ldc;
    DI void operator()(const f32x4 (&acc)[2][2][4][2], const Unit& u, int wr, int wc, int fr, int fq) const {
        const int row0 = u.pm * BM + wr * 64 + fr, col0 = u.pn * BM + wc * 32 + 8 * fq;
#pragma unroll
        for (int ai = 0; ai < 2; ++ai)
#pragma unroll
            for (int m = 0; m < 4; ++m) { bf16_t* rowp = O + (size_t)(row0 + ai * HALF + m * 16) * ldc + col0;
#pragma unroll
                for (int bj = 0; bj < 2; ++bj) { const f32x4 v0 = acc[ai][bj][m][0], v1 = acc[ai][bj][m][1];
                    u32x4 w; w.x = pk2(v0[0], v0[1]); w.y = pk2(v0[2], v0[3]); w.z = pk2(v1[0], v1[1]); w.w = pk2(v1[2], v1[3]);
                    *(u32x4*)(rowp + bj * HALF) = w; } }
    }
};
struct EpiUp {
    static constexpr bool PERM = true;
    bf16_t* O; int ldc; const float* rowss;
    DI void operator()(const f32x4 (&acc)[2][2][4][2], const Unit& u, int wr, int wc, int fr, int fq) const {
        const int row0 = u.pm * BM + wr * 64 + fr, col0 = u.pn * BM + wc * 32 + 8 * fq;
#pragma unroll
        for (int ai = 0; ai < 2; ++ai)
#pragma unroll
            for (int m = 0; m < 4; ++m) { const int r = row0 + ai * HALF + m * 16; bf16_t* rowp = O + (size_t)r * ldc + col0;
                const float rs = rsqrtf(rowss[r] * (1.0f / DM) + EPS);
#pragma unroll
                for (int bj = 0; bj < 2; ++bj) { f32x4 v0 = acc[ai][bj][m][0] * rs, v1 = acc[ai][bj][m][1] * rs;
#pragma unroll
                    for (int j = 0; j < 4; ++j) { const float a = fmaxf(v0[j], 0.f), b = fmaxf(v1[j], 0.f); v0[j] = a * a; v1[j] = b * b; }
                    u32x4 w; w.x = pk2(v0[0], v0[1]); w.y = pk2(v0[2], v0[3]); w.z = pk2(v1[0], v1[1]); w.w = pk2(v1[2], v1[3]);
                    *(u32x4*)(rowp + bj * HALF) = w; } }
    }
};
struct EpiRes1 {
    static constexpr bool PERM = false;
    const float* xp; const float* xs; bf16_t* hb; float* rowss;
    DI void operator()(const f32x4 (&acc)[2][2][4][2], const Unit& u, int wr, int wc, int fr, int fq) const {
        const int col0 = u.pn * BM + wc * 32 + 4 * fq;
#pragma unroll
        for (int ai = 0; ai < 2; ++ai)
#pragma unroll
            for (int m = 0; m < 4; ++m) { const int r = u.pm * BM + ai * HALF + wr * 64 + m * 16 + fr;
                const float* base = r < NTP ? xp + (size_t)r * DM : xs + (size_t)(r - NTP) * DM;
                float ss = 0.f;
#pragma unroll
                for (int bj = 0; bj < 2; ++bj)
#pragma unroll
                    for (int n = 0; n < 2; ++n) { const int c = col0 + bj * HALF + n * 16; const f32x4 o = *(const f32x4*)(base + c) + acc[ai][bj][m][n];
                        ss += (o[0] * o[0] + o[1] * o[1]) + (o[2] * o[2] + o[3] * o[3]);
                        u32x2 w; w.x = pk2(o[0], o[1]); w.y = pk2(o[2], o[3]); *(u32x2*)(hb + (size_t)r * DM + c) = w; }
                ss += __shfl_xor(ss, 16); ss += __shfl_xor(ss, 32);
                if (fq == 0) unsafeAtomicAdd(rowss + r, ss); }
    }
};
template <bool PARTIAL> struct EpiDown {
    static constexpr bool PERM = false;
    bf16_t* hb; float* part;
    DI void operator()(const f32x4 (&acc)[2][2][4][2], const Unit& u, int wr, int wc, int fr, int fq) const {
        const int col0 = u.pn * BM + wc * 32 + 4 * fq;
#pragma unroll
        for (int ai = 0; ai < 2; ++ai)
#pragma unroll
            for (int m = 0; m < 4; ++m) { const int r = u.pm * BM + ai * HALF + wr * 64 + m * 16 + fr;
                float* prow = part + ((size_t)(u.kt0 >> 2) * NTS + (size_t)(r - NTP)) * DM; bf16_t* hrow = hb + (size_t)r * DM;
#pragma unroll
                for (int bj = 0; bj < 2; ++bj)
#pragma unroll
                    for (int n = 0; n < 2; ++n) { const int c = col0 + bj * HALF + n * 16;
                        if (PARTIAL) *(f32x4*)(prow + c) = acc[ai][bj][m][n];
                        else { const u32x2 hw = *(const u32x2*)(hrow + c); const f32x4 a = acc[ai][bj][m][n];
                            u32x2 w; w.x = pk2(bflo(hw.x) + a[0], bfhi(hw.x) + a[1]); w.y = pk2(bflo(hw.y) + a[2], bfhi(hw.y) + a[3]); *(u32x2*)(hrow + c) = w; } } }
    }
};

template <class Epi, class Sched, bool ALIGN_EPI = true, bool OPAQUE_NT = false>
DI void gemm_phase(LAS unsigned char* lds, const Gemm g, const Sched& S, const Epi& E) {
    const int tid = threadIdx.x, wid = __builtin_amdgcn_readfirstlane(tid >> 6), lane = tid & 63, wr = wid >> 2, wc = wid & 3, fr = lane & 15, fq = lane >> 4;
    const int K = g.K; int nt = g.nt; if (OPAQUE_NT) asm volatile("" : "+s"(nt));
    unsigned voffA[2], voffB[2];
#pragma unroll
    for (int i = 0; i < 2; ++i) { int R, C; stage_rc(tid * 16 + i * 8192, R, C); const int Rb = Epi::PERM ? ((R & ~31) + perm32(R & 31)) : R;
        voffA[i] = (unsigned)(R * K + C) * 2u; voffB[i] = (unsigned)(Rb * K + C) * 2u; }
    const size_t kstep = (size_t)(BK * 2);
    const size_t hstep = (size_t)HALF * K * 2;
    const size_t tstep = 2 * hstep;
    const unsigned ldsw = (unsigned)wid * 1024u;
    const int aoff = lds_byte(wr * 64 + fr, fq * 8), boff = lds_byte(wc * 32 + fr, fq * 8);
#define PG8_SA(b, h) (((b) * 2 + (h)) * HTB)
#define PG8_SB(b, h) ((4 + (b) * 2 + (h)) * HTB)
#define PG8_STAGE(bufoff, gbase, voff) do { _Pragma("unroll") for (int _i = 0; _i < 2; ++_i) \
        __builtin_amdgcn_global_load_lds((const unsigned*)((const char*)(gbase) + (voff)[_i]), (LAS unsigned*)(lds + (bufoff) + ldsw + _i * 8192), 16, 0, 0); } while (0)
#define PG8_LDA(dst, b, h) do { _Pragma("unroll") for (int m = 0; m < 4; ++m) _Pragma("unroll") for (int k = 0; k < 2; ++k) dst[m][k] = *(const LAS bf16x8*)(lds + PG8_SA(b, h) + aoff + m * 2048 + k * 1024); } while (0)
#define PG8_LDB(dst, b, h) do { _Pragma("unroll") for (int n = 0; n < 2; ++n) _Pragma("unroll") for (int k = 0; k < 2; ++k) dst[n][k] = *(const LAS bf16x8*)(lds + PG8_SB(b, h) + boff + n * 2048 + k * 1024); } while (0)
#define PG8_MMA(ai, bj, At, Bt) do { __builtin_amdgcn_s_setprio(1); _Pragma("unroll") for (int m = 0; m < 4; ++m) _Pragma("unroll") for (int n = 0; n < 2; ++n) _Pragma("unroll") for (int k = 0; k < 2; ++k) \
        acc[ai][bj][m][n] = __builtin_amdgcn_mfma_f32_16x16x32_bf16(Bt[n][k], At[m][k], acc[ai][bj][m][n], 0, 0, 0); __builtin_amdgcn_s_setprio(0); } while (0)
#define PG8_WAIT_V(n) asm volatile("s_waitcnt vmcnt(" #n ")" ::: "memory")
#define PG8_WAIT_L(n) asm volatile("s_waitcnt lgkmcnt(" #n ")" ::: "memory")
#define PG8_BAR __builtin_amdgcn_s_barrier()
#define PG8_SCHED __builtin_amdgcn_sched_barrier(0)
    Unit cur, nxt; int ui = 0;
    if (!S.next(0, cur)) return;
    f32x4 acc[2][2][4][2];
#pragma unroll
    for (int a = 0; a < 2; ++a)
#pragma unroll
        for (int b = 0; b < 2; ++b)
#pragma unroll
            for (int m = 0; m < 4; ++m)
#pragma unroll
                for (int n = 0; n < 2; ++n) acc[a][b][m][n] = (f32x4){0.f, 0.f, 0.f, 0.f};
    bf16x8 At[4][2], B0[2][2], B1[2][2];
    const char* cA = (const char*)g.A + (size_t)cur.pm * tstep + (size_t)cur.kt0 * kstep; const char* cB = (const char*)g.Bt + (size_t)cur.pn * tstep + (size_t)cur.kt0 * kstep;
    PG8_STAGE(PG8_SB(0, 0), cB, voffB); PG8_STAGE(PG8_SB(0, 1), cB + hstep, voffB); PG8_STAGE(PG8_SA(0, 0), cA, voffA); PG8_STAGE(PG8_SA(0, 1), cA + hstep, voffA);
    if (wr == 1) PG8_BAR;
    PG8_WAIT_V(2); PG8_BAR;
    PG8_STAGE(PG8_SB(1, 0), cB + kstep, voffB); PG8_STAGE(PG8_SA(1, 0), cA + kstep, voffA); PG8_STAGE(PG8_SB(1, 1), cB + hstep + kstep, voffB);
    PG8_WAIT_V(6); PG8_BAR;
    for (;;) {
        const bool has_next = S.next(ui + 1, nxt);
        const char* nA = has_next ? (const char*)g.A + (size_t)nxt.pm * tstep + (size_t)nxt.kt0 * kstep : cA; const char* nB = has_next ? (const char*)g.Bt + (size_t)nxt.pn * tstep + (size_t)nxt.kt0 * kstep : cB;
        for (int t = 0; t < nt; t += 2) {
            const bool last = (t == nt - 2);
            const char* a1 = cA + (size_t)(t + 1) * kstep;
            const char* a2 = last ? nA : cA + (size_t)(t + 2) * kstep; const char* b2 = last ? nB : cB + (size_t)(t + 2) * kstep;
            const char* a3 = a2 + kstep; const char* b3 = b2 + kstep;
            PG8_LDB(B0, 0, 0); PG8_LDB(B1, 0, 1); PG8_SCHED; PG8_LDA(At, 0, 0); PG8_STAGE(PG8_SA(1, 1), a1 + hstep, voffA);
            PG8_WAIT_V(8); PG8_WAIT_L(0); PG8_BAR; PG8_MMA(0, 0, At, B0); PG8_MMA(0, 1, At, B1); PG8_BAR; PG8_SCHED;
            PG8_LDA(At, 0, 1); PG8_STAGE(PG8_SB(0, 0), b2, voffB); PG8_STAGE(PG8_SB(0, 1), b2 + hstep, voffB); PG8_STAGE(PG8_SA(0, 0), a2, voffA);
            PG8_WAIT_V(8); PG8_WAIT_L(0); PG8_BAR; PG8_MMA(1, 0, At, B0); PG8_MMA(1, 1, At, B1); PG8_BAR; PG8_SCHED;
            PG8_LDB(B0, 1, 0); PG8_LDB(B1, 1, 1); PG8_SCHED; PG8_LDA(At, 1, 0); PG8_STAGE(PG8_SA(0, 1), a2 + hstep, voffA);
            PG8_WAIT_V(8); PG8_WAIT_L(0); PG8_BAR; PG8_MMA(0, 0, At, B0); PG8_MMA(0, 1, At, B1); PG8_BAR; PG8_SCHED;
            PG8_LDA(At, 1, 1); PG8_STAGE(PG8_SB(1, 0), b3, voffB); PG8_STAGE(PG8_SB(1, 1), b3 + hstep, voffB); PG8_STAGE(PG8_SA(1, 0), a3, voffA);
            PG8_WAIT_V(8); PG8_WAIT_L(0); PG8_BAR; PG8_MMA(1, 0, At, B0); PG8_MMA(1, 1, At, B1); PG8_BAR; PG8_SCHED;
        }
        if constexpr (ALIGN_EPI) { if (wr == 0) PG8_BAR; }
        E(acc, cur, wr, wc, fr, fq);
        if (!has_next) break;
#pragma unroll
        for (int a = 0; a < 2; ++a)
#pragma unroll
            for (int b = 0; b < 2; ++b)
#pragma unroll
                for (int m = 0; m < 4; ++m)
#pragma unroll
                    for (int n = 0; n < 2; ++n) acc[a][b][m][n] = (f32x4){0.f, 0.f, 0.f, 0.f};
        cur = nxt; cA = nA; cB = nB; ++ui;
        if constexpr (ALIGN_EPI) { if (wr == 1) PG8_BAR; }
    }
    PG8_WAIT_V(0);
    if constexpr (!ALIGN_EPI) { if (wr == 0) PG8_BAR; }
    PG8_BAR;
#undef PG8_SA
#undef PG8_SB
#undef PG8_STAGE
#undef PG8_LDA
#undef PG8_LDB
#undef PG8_MMA
#undef PG8_WAIT_V
#undef PG8_WAIT_L
#undef PG8_BAR
#undef PG8_SCHED
}
}

struct Ptrs {
    const float *x_p, *x_s, *state, *ck, *cv, *ln_mix, *w_in, *lb_logits, *hg_norm, *sinks, *w_out, *ln_mlp, *w_up, *w_down, *ln_final;
    float* out;
    bf16_t *WinT, *WoutT, *WupT, *WdnT, *XN, *Z, *MIX, *U;
    float *HS, *DSC, *rss1, *rss2, *PART;
};

DI void p0_transpose_item(const float* W, int K, int N, bf16_t* WT, const float* kscale, LAS float* scr, int item, int lane) {
    const int nblk = N / 32, kb = item / nblk, nb = item % nblk, k0 = 64 * kb, n0 = 32 * nb;
    float wv[32];
#pragma unroll
    for (int i = 0; i < 32; ++i) wv[i] = W[(size_t)(k0 + 2 * i + (lane >> 5)) * N + n0 + (lane & 31)];
#pragma unroll
    for (int i = 0; i < 32; ++i) { const int kk = 2 * i + (lane >> 5); float v = wv[i]; if (kscale) v *= kscale[k0 + kk]; scr[kk * 33 + (lane & 31)] = v; }
    asm volatile("s_waitcnt lgkmcnt(0)" ::: "memory");
    const int c = lane & 7;
#pragma unroll
    for (int j = 0; j < 4; ++j) { const int n = (lane >> 3) + 8 * j; const LAS float* s = scr + (8 * c) * 33 + n;
        u32x4 o; o.x = pk2(s[0 * 33], s[1 * 33]); o.y = pk2(s[2 * 33], s[3 * 33]); o.z = pk2(s[4 * 33], s[5 * 33]); o.w = pk2(s[6 * 33], s[7 * 33]);
        *(u32x4*)(WT + (size_t)(n0 + n) * K + k0 + 8 * c) = o; }
    asm volatile("s_waitcnt lgkmcnt(0)" ::: "memory");
}
DI void p0_prologue(LAS unsigned char* lds, const Ptrs& P, int G) {
    const int tid = threadIdx.x, lane = tid & 63, wave = __builtin_amdgcn_readfirstlane(tid >> 6);
    LAS float* scr = (LAS float*)(lds + wave * 16384);
    const int gw = blockIdx.x * 8 + wave, NGW = G * 8;
    constexpr int I_IN = (DM / 64) * (NIN / 32), I_O = (DM / 64) * (DM / 32), I_UP = (DM / 64) * (FF / 32), I_DN = (FF / 64) * (DM / 32);
    constexpr int NITEMS = I_IN + I_O + I_UP + I_DN;
    for (int it = gw; it < NITEMS; it += NGW) {
        int r = it;
        if (r < I_IN) { p0_transpose_item(P.w_in, DM, NIN, P.WinT, nullptr, scr, r, lane); continue; } r -= I_IN;
        if (r < I_O) { p0_transpose_item(P.w_out, DM, DM, P.WoutT, nullptr, scr, r, lane); continue; } r -= I_O;
        if (r < I_UP) { p0_transpose_item(P.w_up, DM, FF, P.WupT, P.ln_mlp, scr, r, lane); continue; } r -= I_UP;
        p0_transpose_item(P.w_down, FF, DM, P.WdnT, nullptr, scr, r, lane);
    }
    f32x4 gv[4];
#pragma unroll
    for (int j = 0; j < 4; ++j) gv[j] = *((const f32x4*)P.ln_mix + lane + 64 * j);
    for (int m0 = gw; m0 < M; m0 += 2 * NGW) {
        const int m1 = m0 + NGW; const bool has1 = m1 < M; const int mm1 = has1 ? m1 : m0;
        const f32x4* xr0 = (const f32x4*)(m0 < NTP ? P.x_p + (size_t)m0 * DM : P.x_s + (size_t)(m0 - NTP) * DM) + lane;
        const f32x4* xr1 = (const f32x4*)(mm1 < NTP ? P.x_p + (size_t)mm1 * DM : P.x_s + (size_t)(mm1 - NTP) * DM) + lane;
        f32x4 v0[4], v1[4]; float s0 = 0.f, s1 = 0.f;
#pragma unroll
        for (int j = 0; j < 4; ++j) { v0[j] = xr0[64 * j]; v1[j] = xr1[64 * j]; }
#pragma unroll
        for (int j = 0; j < 4; ++j) { s0 += (v0[j].x * v0[j].x + v0[j].y * v0[j].y) + (v0[j].z * v0[j].z + v0[j].w * v0[j].w); s1 += (v1[j].x * v1[j].x + v1[j].y * v1[j].y) + (v1[j].z * v1[j].z + v1[j].w * v1[j].w); }
        const float r0 = rsqrtf(wave_sum(s0) * (1.f / DM) + EPS), r1 = rsqrtf(wave_sum(s1) * (1.f / DM) + EPS);
        unsigned long long* o0 = (unsigned long long*)(P.XN + (size_t)m0 * DM) + lane; unsigned long long* o1 = (unsigned long long*)(P.XN + (size_t)mm1 * DM) + lane;
#pragma unroll
        for (int j = 0; j < 4; ++j) { const f32x4 w = v0[j] * r0 * gv[j]; o0[64 * j] = (unsigned long long)pk2(w.x, w.y) | ((unsigned long long)pk2(w.z, w.w) << 32); }
        if (has1) {
#pragma unroll
            for (int j = 0; j < 4; ++j) { const f32x4 w = v1[j] * r1 * gv[j]; o1[64 * j] = (unsigned long long)pk2(w.x, w.y) | ((unsigned long long)pk2(w.z, w.w) << 32); }
        }
    }
    for (int i = blockIdx.x * 512 + tid; i < M; i += G * 512) P.rss1[i] = 0.f;
}

constexpr int HSTR = 136, HROWB = HSTR * 2;
constexpr int OFF_QT = 0, OFF_KT = 128 * HROWB, OFF_KET = 2 * 128 * HROWB, OFF_VT = 3 * 128 * HROWB, OFF_DEC = 4 * 128 * HROWB, OFF_SS = OFF_DEC + 2048, OFF_AT = OFF_SS + 2048;
static_assert(OFF_AT + 8192 <= LDS_MISC, "hgrn lds");
template <bool FULL>
DI void hgrn_unit(LAS unsigned char* lds, const Ptrs& P, int unit) {
    const int tid = threadIdx.x, lane = tid & 63, wid = __builtin_amdgcn_readfirstlane(tid >> 6), r32 = lane & 31, hi = lane >> 5;
    const int bh = unit >> 5, sc = unit & 31, b = bh >> 2, h = bh & 3;
    const size_t row0 = (size_t)b * SEQ + sc * 128;
    LAS float* DEC = (LAS float*)(lds + OFF_DEC);
    LAS float* SSb = (LAS float*)(lds + OFF_SS);
    const bool act = wid < 4; const int vb = wid & 3, dh = wid >> 2;
    float* HSu = P.HS + (size_t)unit * 16384;
    f32x16 S[4];
    if (FULL) {
#pragma unroll
        for (int i = 0; i < 4; ++i)
#pragma unroll
            for (int r = 0; r < 16; ++r) S[i][r] = act ? HSu[(32 * i + crow(r, hi)) * 128 + vb * 32 + r32] : 0.f;
    } else {
#pragma unroll
        for (int i = 0; i < 4; ++i)
#pragma unroll
            for (int r = 0; r < 16; ++r) S[i][r] = 0.f;
    }
    {
        const int c = tid >> 7, d = tid & 127;
        const float l0 = P.lb_logits[h * 128 + d], l1 = P.lb_logits[512 + h * 128 + d];
        const float lbv = 1.f / (1.f + __expf(l1 - l0)), oml = 1.f - lbv;
        const bf16_t* zrow = P.Z + (row0 + c * 32) * NIN + h * 128 + d;
        float ke[32];
        if (FULL) {
            float eb = 1.f;
#pragma unroll
            for (int t = 0; t < 32; ++t) {
                float zf = bf2f(zrow[(size_t)t * NIN + ZF]); zf = fminf(fmaxf(zf, -30.f), 30.f);
                const float e = __expf(-zf), sg = __builtin_amdgcn_rcpf(1.f + e);
                const float f = lbv + oml * sg, k = oml * e * sg;
                eb *= f;
                const float ieb = __builtin_amdgcn_rcpf(eb);
                const float zq = bf2f(zrow[(size_t)t * NIN + ZQ]);
                const float q = zq * __builtin_amdgcn_rcpf(1.f + __expf(-zq));
                const float ktv = k * ieb; ke[t] = ktv;
                *(LAS bf16_t*)(lds + OFF_QT + (c * 32 + t) * HROWB + d * 2) = (bf16_t)(pk2(q * eb, 0.f) & 0xffffu);
                *(LAS bf16_t*)(lds + OFF_KT + (c * 32 + t) * HROWB + d * 2) = (bf16_t)(pk2(ktv, 0.f) & 0xffffu);
            }
            DEC[c * 128 + d] = eb;
#pragma unroll
            for (int t = 0; t < 32; ++t) ke[t] *= eb;
        } else {
            float sp = 1.f;
#pragma unroll
            for (int t = 31; t >= 0; --t) {
                float zf = bf2f(zrow[(size_t)t * NIN + ZF]); zf = fminf(fmaxf(zf, -30.f), 30.f);
                const float e = __expf(-zf), sg = __builtin_amdgcn_rcpf(1.f + e);
                const float f = lbv + oml * sg, k = oml * e * sg;
                ke[t] = k * sp; sp *= f;
            }
            DEC[c * 128 + d] = sp;
        }
#pragma unroll
        for (int t8 = 0; t8 < 4; ++t8) {
            u32x4 w; w.x = pk2(ke[8 * t8 + 0], ke[8 * t8 + 1]); w.y = pk2(ke[8 * t8 + 2], ke[8 * t8 + 3]); w.z = pk2(ke[8 * t8 + 4], ke[8 * t8 + 5]); w.w = pk2(ke[8 * t8 + 6], ke[8 * t8 + 7]);
            *(LAS u32x4*)(lds + OFF_KET + d * HROWB + (c * 32 + 8 * t8) * 2) = w;
        }
#pragma unroll
        for (int t8 = 0; t8 < 4; ++t8) {
            unsigned v[8];
#pragma unroll
            for (int j = 0; j < 8; ++j) v[j] = zrow[(size_t)(8 * t8 + j) * NIN + ZI];
            u32x4 w; w.x = v[0] | (v[1] << 16); w.y = v[2] | (v[3] << 16); w.z = v[4] | (v[5] << 16); w.w = v[6] | (v[7] << 16);
            *(LAS u32x4*)(lds + OFF_VT + d * HROWB + (c * 32 + 8 * t8) * 2) = w;
        }
    }
    __syncthreads();
    if (!FULL) {
#pragma unroll 1
        for (int c = 0; c < 4; ++c) {
#pragma unroll
            for (int ii = 0; ii < 2; ++ii) {
                const int i = 2 * dh + ii;
#pragma unroll
                for (int g4 = 0; g4 < 4; ++g4) { const f32x4 dv = *(const LAS f32x4*)(DEC + c * 128 + 32 * i + 8 * g4 + 4 * hi);
#pragma unroll
                    for (int j = 0; j < 4; ++j) S[ii][4 * g4 + j] *= dv[j]; }
#pragma unroll
                for (int k2 = 0; k2 < 2; ++k2) {
                    const bf16x8 a = *(const LAS bf16x8*)(lds + OFF_KET + (32 * i + r32) * HROWB + (c * 32 + 16 * k2 + 8 * hi) * 2);
                    const bf16x8 bv = *(const LAS bf16x8*)(lds + OFF_VT + (vb * 32 + r32) * HROWB + (c * 32 + 16 * k2 + 8 * hi) * 2);
                    S[ii] = MFMA32(a, bv, S[ii]);
                }
            }
        }
#pragma unroll
        for (int ii = 0; ii < 2; ++ii)
#pragma unroll
            for (int r = 0; r < 16; ++r) HSu[(32 * (2 * dh + ii) + crow(r, hi)) * 128 + vb * 32 + r32] = S[ii][r];
        if (tid < 128) P.DSC[unit * 128 + tid] = (DEC[tid] * DEC[128 + tid]) * (DEC[256 + tid] * DEC[384 + tid]);
        __syncthreads();
        return;
    }
    if (!act) {
        const int c = wid - 4;
        f32x16 a0, a1;
#pragma unroll
        for (int r = 0; r < 16; ++r) { a0[r] = 0.f; a1[r] = 0.f; }
#pragma unroll
        for (int ks = 0; ks < 8; ks += 2) {
            const bf16x8 ka = *(const LAS bf16x8*)(lds + OFF_KT + (c * 32 + r32) * HROWB + (ks * 16 + 8 * hi) * 2);
            const bf16x8 qa = *(const LAS bf16x8*)(lds + OFF_QT + (c * 32 + r32) * HROWB + (ks * 16 + 8 * hi) * 2);
            const bf16x8 kb = *(const LAS bf16x8*)(lds + OFF_KT + (c * 32 + r32) * HROWB + (ks * 16 + 16 + 8 * hi) * 2);
            const bf16x8 qb = *(const LAS bf16x8*)(lds + OFF_QT + (c * 32 + r32) * HROWB + (ks * 16 + 16 + 8 * hi) * 2);
            a0 = MFMA32(ka, qa, a0); a1 = MFMA32(kb, qb, a1);
        }
#pragma unroll
        for (int r = 0; r < 16; ++r) a0[r] = (crow(r, hi) > r32) ? 0.f : (a0[r] + a1[r]);
#pragma unroll
        for (int s2 = 0; s2 < 2; ++s2) *(LAS bf16x8*)(lds + OFF_AT + ((c * 2 + s2) * 64 + lane) * 16) = packs(a0, s2);
    }
    __syncthreads();
    f32x16 o[4];
    if (act) {
#pragma unroll
        for (int c = 0; c < 4; ++c) {
            f32x16 oa, ob;
#pragma unroll
            for (int r = 0; r < 16; ++r) { oa[r] = 0.f; ob[r] = 0.f; }
#pragma unroll
            for (int s2 = 0; s2 < 2; ++s2) {
                const bf16x8 pa = *(const LAS bf16x8*)(lds + OFF_AT + ((c * 2 + s2) * 64 + lane) * 16);
                const LAS unsigned char* vp = lds + OFF_VT + (vb * 32 + r32) * HROWB + (c * 32 + 16 * s2 + 4 * hi) * 2;
                const bf16x8 av = cat4(*(const LAS s16x4*)vp, *(const LAS s16x4*)(vp + 16));
                oa = MFMA32(av, pa, oa);
            }
#pragma unroll
            for (int i = 0; i < 4; ++i)
#pragma unroll
                for (int s2 = 0; s2 < 2; ++s2) {
                    const bf16x8 sa = packs(S[i], s2);
                    const LAS unsigned char* qp = lds + OFF_QT + (c * 32 + r32) * HROWB + (32 * i + 16 * s2 + 4 * hi) * 2;
                    const bf16x8 bq = cat4(*(const LAS s16x4*)qp, *(const LAS s16x4*)(qp + 16));
                    if (i < 2) ob = MFMA32(sa, bq, ob); else oa = MFMA32(sa, bq, oa);
                }
#pragma unroll
            for (int i = 0; i < 4; ++i) {
#pragma unroll
                for (int g4 = 0; g4 < 4; ++g4) { const f32x4 dv = *(const LAS f32x4*)(DEC + c * 128 + 32 * i + 8 * g4 + 4 * hi);
#pragma unroll
                    for (int j = 0; j < 4; ++j) S[i][4 * g4 + j] *= dv[j]; }
#pragma unroll
                for (int k2 = 0; k2 < 2; ++k2) {
                    const bf16x8 a = *(const LAS bf16x8*)(lds + OFF_KET + (32 * i + r32) * HROWB + (c * 32 + 16 * k2 + 8 * hi) * 2);
                    const bf16x8 bv = *(const LAS bf16x8*)(lds + OFF_VT + (vb * 32 + r32) * HROWB + (c * 32 + 16 * k2 + 8 * hi) * 2);
                    S[i] = MFMA32(a, bv, S[i]);
                }
            }
            float ss = 0.f;
#pragma unroll
            for (int r = 0; r < 16; ++r) { o[c][r] = oa[r] + ob[r]; ss += o[c][r] * o[c][r]; }
            ss += __shfl_xor(ss, 32);
            if (hi == 0) SSb[(c * 4 + wid) * 32 + r32] = ss;
        }
    }
    u32x2 zgv[4][4];
    if (act) {
#pragma unroll
        for (int c = 0; c < 4; ++c)
#pragma unroll
            for (int g4 = 0; g4 < 4; ++g4) zgv[c][g4] = *(const u32x2*)(P.Z + (row0 + c * 32 + r32) * NIN + ZG + h * 128 + vb * 32 + 8 * g4 + 4 * hi);
    }
    __syncthreads();
    if (act) {
#pragma unroll
        for (int c = 0; c < 4; ++c) {
            const float tot = (SSb[(c * 4 + 0) * 32 + r32] + SSb[(c * 4 + 1) * 32 + r32]) + (SSb[(c * 4 + 2) * 32 + r32] + SSb[(c * 4 + 3) * 32 + r32]);
            const float rstd = rsqrtf(tot * (1.f / 128.f) + EPS);
            const size_t row = row0 + c * 32 + r32;
#pragma unroll
            for (int g4 = 0; g4 < 4; ++g4) {
                const int v0 = vb * 32 + 8 * g4 + 4 * hi;
                const u32x2 zg = zgv[c][g4];
                const f32x4 gn = *(const f32x4*)(P.hg_norm + v0);
                float gz[4] = {bflo(zg.x), bfhi(zg.x), bflo(zg.y), bfhi(zg.y)}; float ov[4];
#pragma unroll
                for (int j = 0; j < 4; ++j) ov[j] = o[c][4 * g4 + j] * rstd * gn[j] * (gz[j] * __builtin_amdgcn_rcpf(1.f + __expf(-gz[j])));
                u32x2 w; w.x = pk2(ov[0], ov[1]); w.y = pk2(ov[2], ov[3]);
                *(u32x2*)(P.MIX + row * DM + h * 128 + v0) = w;
            }
        }
    }
    __syncthreads();
}

template <class MaskF>
DI void swa_tile(const LAS unsigned char* KSb, int kstrideB, const LAS unsigned char* VTb, int vstrideB, const bf16x8 (&qf)[4], float sink, MaskF valid, bf16_t* orow, int r32, int hi) {
    f32x16 st[5];
#pragma unroll
    for (int kt = 0; kt < 5; ++kt) {
#pragma unroll
        for (int r = 0; r < 16; ++r) st[kt][r] = 0.f;
#pragma unroll
        for (int ks = 0; ks < 4; ++ks) { const bf16x8 a = *(const LAS bf16x8*)(KSb + (32 * kt + r32) * kstrideB + (16 * ks + 8 * hi) * 2); st[kt] = MFMA32(a, qf[ks], st[kt]); }
    }
    float m = sink;
#pragma unroll
    for (int kt = 0; kt < 5; ++kt)
#pragma unroll
        for (int r = 0; r < 16; ++r) { const int jr = 32 * kt + crow(r, hi); const float s = valid(jr) ? st[kt][r] * 0.125f : -INFINITY; st[kt][r] = s; m = fmaxf(m, s); }
    m = fmaxf(m, __shfl_xor(m, 32));
    float den = 0.f;
#pragma unroll
    for (int kt = 0; kt < 5; ++kt)
#pragma unroll
        for (int r = 0; r < 16; ++r) { const float p = __expf(st[kt][r] - m); st[kt][r] = p; den += p; }
    den += __shfl_xor(den, 32);
    den += __expf(sink - m);
    f32x16 o[2];
#pragma unroll
    for (int r = 0; r < 16; ++r) { o[0][r] = 0.f; o[1][r] = 0.f; }
#pragma unroll
    for (int kt = 0; kt < 5; ++kt)
#pragma unroll
        for (int s2 = 0; s2 < 2; ++s2) {
            const bf16x8 pb = packs(st[kt], s2);
#pragma unroll
            for (int dt = 0; dt < 2; ++dt) {
                const LAS unsigned char* vp = VTb + (32 * dt + r32) * vstrideB + (32 * kt + 16 * s2 + 4 * hi) * 2;
                const bf16x8 av = cat4(*(const LAS s16x4*)vp, *(const LAS s16x4*)(vp + 16));
                o[dt] = MFMA32(av, pb, o[dt]);
            }
        }
    const float inv = 1.f / den;
#pragma unroll
    for (int dt = 0; dt < 2; ++dt)
#pragma unroll
        for (int g4 = 0; g4 < 4; ++g4) { const int d0 = 32 * dt + 8 * g4 + 4 * hi;
            u32x2 w; w.x = pk2(o[dt][4 * g4] * inv, o[dt][4 * g4 + 1] * inv); w.y = pk2(o[dt][4 * g4 + 2] * inv, o[dt][4 * g4 + 3] * inv);
            *(u32x2*)(orow + d0) = w; }
}

constexpr int PK_STRB = 144, PV_STRB = 528, P_OFF_V = 256 * PK_STRB;
DI void swa_prompt_unit(LAS unsigned char* lds, const Ptrs& P, int unit) {
    const int tid = threadIdx.x, lane = tid & 63, wid = __builtin_amdgcn_readfirstlane(tid >> 6), r32 = lane & 31, hi = lane >> 5;
    const int kvh = unit & 1, n = (unit >> 1) & 31, b = unit >> 6;
    const long rowk0 = (long)b * SEQ + (long)(n - 1) * 128;
    const int g = wid >> 1, half = wid & 1, qh = kvh * 4 + g;
    bf16x8 qf[2][4];
#pragma unroll
    for (int sub = 0; sub < 2; ++sub)
#pragma unroll
        for (int ks = 0; ks < 4; ++ks) qf[sub][ks] = *(const bf16x8*)(P.Z + ((size_t)b * SEQ + n * 128 + 64 * half + 32 * sub + r32) * NIN + ZSQ + qh * 64 + 16 * ks + 8 * hi);
#pragma unroll
    for (int i = 0; i < 4; ++i) {
        const int q = tid + 512 * i, j = q >> 3, part = q & 7;
        u32x4 kv = (u32x4){0u, 0u, 0u, 0u}, vv = (u32x4){0u, 0u, 0u, 0u};
        if (n > 0 || j >= 128) { const bf16_t* zr = P.Z + (size_t)(rowk0 + j) * NIN + kvh * 64 + part * 8; kv = *(const u32x4*)(zr + ZSK); vv = *(const u32x4*)(zr + ZSV); }
        *(LAS u32x4*)(lds + j * PK_STRB + part * 16) = kv;
        LAS bf16_t* vt = (LAS bf16_t*)(lds + P_OFF_V + (part * 8) * PV_STRB + j * 2);
        const unsigned vw[4] = {vv.x, vv.y, vv.z, vv.w};
#pragma unroll
        for (int e = 0; e < 4; ++e) { vt[(2 * e) * (PV_STRB / 2)] = (bf16_t)(vw[e] & 0xffffu); vt[(2 * e + 1) * (PV_STRB / 2)] = (bf16_t)(vw[e] >> 16); }
    }
    __syncthreads();
    const float sink = P.sinks[qh];
    const int jmin = n == 0 ? 128 : 0;
#pragma unroll
    for (int sub = 0; sub < 2; ++sub) {
        const int i0 = 64 * half + 32 * sub;
        const size_t row = (size_t)b * SEQ + n * 128 + i0 + r32;
        auto valid = [=](int jr) { return (jr > r32) && (jr <= r32 + 128) && (i0 + jr >= jmin); };
        swa_tile(lds + i0 * PK_STRB, PK_STRB, lds + P_OFF_V + i0 * 2, PV_STRB, qf[sub], sink, valid, P.MIX + row * DM + 512 + qh * 64, r32, hi);
    }
    __syncthreads();
}

constexpr int SK_STRB = 144, SV_STRB = 336, S_OFF_V = 2 * 160 * SK_STRB;
static_assert(S_OFF_V + 2 * 64 * SV_STRB <= LDS_BYTES, "swa sample lds");
DI void swa_sample_unit(LAS unsigned char* lds, const Ptrs& P, int b) {
    const int tid = threadIdx.x, lane = tid & 63, wid = __builtin_amdgcn_readfirstlane(tid >> 6), r32 = lane & 31, hi = lane >> 5;
    float* okb = P.out + O_KS + (size_t)b * 16384; float* ovb = P.out + O_VS + (size_t)b * 16384;
#pragma unroll
    for (int i = 0; i < 8; ++i) {
        const int q = tid + 512 * i, j = q >> 5, c4 = q & 31, kvh = c4 >> 4, d0 = (c4 & 15) * 4;
        const f32x4 kf = *(const f32x4*)(P.ck + (size_t)b * 16384 + j * 128 + c4 * 4);
        const f32x4 vf = *(const f32x4*)(P.cv + (size_t)b * 16384 + j * 128 + c4 * 4);
        if (j >= 8) { *(f32x4*)(okb + (j - 8) * 128 + c4 * 4) = kf; *(f32x4*)(ovb + (j - 8) * 128 + c4 * 4) = vf; }
        u32x2 kw; kw.x = pk2(kf[0], kf[1]); kw.y = pk2(kf[2], kf[3]);
        *(LAS u32x2*)(lds + (kvh * 160 + j) * SK_STRB + d0 * 2) = kw;
        const unsigned v01 = pk2(vf[0], vf[1]), v23 = pk2(vf[2], vf[3]);
        LAS bf16_t* vt = (LAS bf16_t*)(lds + S_OFF_V + (kvh * 64 + d0) * SV_STRB + j * 2);
        vt[0] = (bf16_t)(v01 & 0xffffu); vt[SV_STRB / 2] = (bf16_t)(v01 >> 16); vt[2 * (SV_STRB / 2)] = (bf16_t)(v23 & 0xffffu); vt[3 * (SV_STRB / 2)] = (bf16_t)(v23 >> 16);
    }
    for (int e = tid; e < 2048; e += 512) {
        const int isv = e >> 10, s = (e >> 7) & 7, c = e & 127, kvh = c >> 6, d = c & 63;
        const bf16_t raw = P.Z[(size_t)(NTP + b * 8 + s) * NIN + (isv ? ZSV : ZSK) + c];
        (isv ? ovb : okb)[(120 + s) * 128 + c] = bf2f(raw);
        if (isv) *(LAS bf16_t*)(lds + S_OFF_V + (kvh * 64 + d) * SV_STRB + (128 + s) * 2) = raw;
        else *(LAS bf16_t*)(lds + (kvh * 160 + 128 + s) * SK_STRB + d * 2) = raw;
    }
    for (int e = tid; e < 2 * 24 * 64; e += 512) {
        const int kvh = e / 1536, rem = e % 1536, jj = rem >> 6, d = rem & 63;
        *(LAS bf16_t*)(lds + (kvh * 160 + 136 + jj) * SK_STRB + d * 2) = 0;
        *(LAS bf16_t*)(lds + S_OFF_V + (kvh * 64 + d) * SV_STRB + (136 + jj) * 2) = 0;
    }
    __syncthreads();
    if (wid < 2) {
        const int kvh = wid, g = r32 >> 3, s = r32 & 7, qh = kvh * 4 + g;
        const size_t row = (size_t)NTP + b * 8 + s;
        auto valid = [=](int jr) { return jr < 128 ? (jr > s) : (jr - 128 <= s); };
        bf16x8 qf[4];
#pragma unroll
        for (int ks = 0; ks < 4; ++ks) qf[ks] = *(const bf16x8*)(P.Z + row * NIN + ZSQ + qh * 64 + 16 * ks + 8 * hi);
        swa_tile(lds + kvh * 160 * SK_STRB, SK_STRB, lds + S_OFF_V + kvh * 64 * SV_STRB, SV_STRB, qf, P.sinks[qh], valid, P.MIX + row * DM + 512 + qh * 64, r32, hi);
    }
    __syncthreads();
}

DI void hgrn_sample_unit(LAS unsigned char* lds, const Ptrs& P, int unit) {
    const int tid = threadIdx.x, lane = tid & 63, wid = __builtin_amdgcn_readfirstlane(tid >> 6), hi = lane >> 5;
    const int b = unit >> 2, h = unit & 3;
    const int dg = tid >> 5, vq = tid & 31;
    const size_t soff = ((size_t)unit * 128 + dg * 8) * 128 + vq * 4;
    f32x4 S[8];
#pragma unroll
    for (int i = 0; i < 8; ++i) S[i] = *(const f32x4*)(P.state + soff + i * 128);
    LAS float* Fs = (LAS float*)lds; LAS float* Ks = Fs + 1024; LAS float* Qs = Ks + 1024; LAS float* Vs = Qs + 1024; LAS float* Gs = Vs + 1024; LAS float* OP = Gs + 1024;
    for (int e = tid; e < 1024; e += 512) {
        const int t = e >> 7, d = e & 127;
        const bf16_t* zr = P.Z + (size_t)(NTP + b * 8 + t) * NIN + h * 128 + d;
        const float zq = bf2f(zr[ZQ]), zi = bf2f(zr[ZI]), zg = bf2f(zr[ZG]); float zf = bf2f(zr[ZF]); zf = fminf(fmaxf(zf, -30.f), 30.f);
        const float l0 = P.lb_logits[h * 128 + d], l1 = P.lb_logits[512 + h * 128 + d];
        const float lbv = 1.f / (1.f + __expf(l1 - l0)), oml = 1.f - lbv;
        const float ex = __expf(-zf), sg = 1.f / (1.f + ex);
        Fs[e] = lbv + oml * sg; Ks[e] = oml * ex * sg; Qs[e] = zq / (1.f + __expf(-zq)); Vs[e] = zi; Gs[e] = zg / (1.f + __expf(-zg));
    }
    __syncthreads();
#pragma unroll 1
    for (int t = 0; t < 8; ++t) {
        const f32x4 v = *(const LAS f32x4*)(Vs + t * 128 + vq * 4); f32x4 op = (f32x4){0.f, 0.f, 0.f, 0.f};
#pragma unroll
        for (int i = 0; i < 8; ++i) { const int d = dg * 8 + i; const float f = Fs[t * 128 + d], k = Ks[t * 128 + d], q = Qs[t * 128 + d];
            S[i] = S[i] * f + v * k; op += S[i] * q; }
#pragma unroll
        for (int j = 0; j < 4; ++j) op[j] += __shfl_xor(op[j], 32);
        if (hi == 0) *(LAS f32x4*)(OP + (t * 8 + wid) * 128 + vq * 4) = op;
    }
    float* so = P.out + O_SS + soff;
#pragma unroll
    for (int i = 0; i < 8; ++i) *(f32x4*)(so + i * 128) = S[i];
    __syncthreads();
    {
        const int t = wid; float o0 = 0.f, o1 = 0.f;
#pragma unroll
        for (int w = 0; w < 8; ++w) { o0 += OP[(t * 8 + w) * 128 + lane]; o1 += OP[(t * 8 + w) * 128 + 64 + lane]; }
        const float rstd = rsqrtf(wave_sum(o0 * o0 + o1 * o1) * (1.f / 128.f) + EPS);
        bf16_t* mo = P.MIX + (size_t)(NTP + b * 8 + t) * DM + h * 128;
        mo[lane] = (bf16_t)(pk2(o0 * rstd * P.hg_norm[lane] * Gs[t * 128 + lane], 0.f) & 0xffffu);
        mo[64 + lane] = (bf16_t)(pk2(o1 * rstd * P.hg_norm[64 + lane] * Gs[t * 128 + 64 + lane], 0.f) & 0xffffu);
    }
    __syncthreads();
}

DI void scan_phase(const Ptrs& P, int G, int skip) {
    if ((int)blockIdx.x < skip) return;
    const int gt = ((int)blockIdx.x - skip) * 512 + threadIdx.x, NT = (G - skip) * 512;
    for (int idx4 = gt; idx4 < 32 * 4096; idx4 += NT) {
        const int bh = idx4 >> 12, e = (idx4 & 4095) * 4, d = e >> 7;
        float* hp = P.HS + (size_t)bh * 32 * 16384 + e; const float* dp = P.DSC + bh * 32 * 128 + d;
        f32x4 S = (f32x4){0.f, 0.f, 0.f, 0.f};
#pragma unroll 1
        for (int s0 = 0; s0 < 32; s0 += 8) {
            f32x4 Hv[8]; float dv[8];
#pragma unroll
            for (int j = 0; j < 8; ++j) { Hv[j] = *(const f32x4*)(hp + (size_t)(s0 + j) * 16384); dv[j] = dp[(s0 + j) * 128]; }
#pragma unroll
            for (int j = 0; j < 8; ++j) { *(f32x4*)(hp + (size_t)(s0 + j) * 16384) = S; S = S * dv[j] + Hv[j]; }
        }
        *(f32x4*)(P.out + O_SP + (size_t)bh * 16384 + e) = S;
    }
    for (int e = gt; e < 8 * 128 * 256; e += NT) {
        const int b = e >> 15, j = (e >> 8) & 127, c = e & 255;
        const float v = bf2f(P.Z[(size_t)(b * SEQ + SEQ - 128 + j) * NIN + ZSK + c]);
        if (c < 128) P.out[O_KP + (size_t)(b * 128 + j) * 128 + c] = v; else P.out[O_VP + (size_t)(b * 128 + j) * 128 + (c - 128)] = v;
    }
}

DI void final_norm(const Ptrs& P, int G) {
    const int tid = threadIdx.x, lane = tid & 63, wave = tid >> 6;
    const int gw = blockIdx.x * 8 + wave, NGW = G * 8;
    f32x4 ga[2], gb[2];
#pragma unroll
    for (int j = 0; j < 2; ++j) { ga[j] = *(const f32x4*)(P.ln_final + 8 * lane + 512 * j); gb[j] = *(const f32x4*)(P.ln_final + 8 * lane + 512 * j + 4); }
    for (int m0 = gw; m0 < NTP; m0 += 4 * NGW) {
        u32x4 w[4][2]; bool has[4]; int mm[4];
#pragma unroll
        for (int q = 0; q < 4; ++q) { const int m = m0 + q * NGW; has[q] = m < NTP; mm[q] = has[q] ? m : m0;
#pragma unroll
            for (int j = 0; j < 2; ++j) w[q][j] = *(const u32x4*)(P.XN + (size_t)mm[q] * DM + 8 * lane + 512 * j); }
#pragma unroll
        for (int q = 0; q < 4; ++q) {
            f32x4 va[2], vb[2]; float s = 0.f;
#pragma unroll
            for (int j = 0; j < 2; ++j) { va[j] = (f32x4){bflo(w[q][j].x), bfhi(w[q][j].x), bflo(w[q][j].y), bfhi(w[q][j].y)}; vb[j] = (f32x4){bflo(w[q][j].z), bfhi(w[q][j].z), bflo(w[q][j].w), bfhi(w[q][j].w)};
                s += (va[j].x * va[j].x + va[j].y * va[j].y) + (va[j].z * va[j].z + va[j].w * va[j].w) + (vb[j].x * vb[j].x + vb[j].y * vb[j].y) + (vb[j].z * vb[j].z + vb[j].w * vb[j].w); }
            const float r = rsqrtf(wave_sum(s) * (1.f / DM) + EPS);
            if (has[q]) { float* yo = P.out + (size_t)mm[q] * DM + 8 * lane;
#pragma unroll
                for (int j = 0; j < 2; ++j) { *(f32x4*)(yo + 512 * j) = va[j] * r * ga[j]; *(f32x4*)(yo + 512 * j + 4) = vb[j] * r * gb[j]; } }
        }
    }
    for (int m = NTP + gw; m < M; m += NGW) {
        f32x4 va[2], vb[2]; float s = 0.f;
#pragma unroll
        for (int j = 0; j < 2; ++j) { const u32x4 w = *(const u32x4*)(P.XN + (size_t)m * DM + 8 * lane + 512 * j);
            va[j] = (f32x4){bflo(w.x), bfhi(w.x), bflo(w.y), bfhi(w.y)}; vb[j] = (f32x4){bflo(w.z), bfhi(w.z), bflo(w.w), bfhi(w.w)}; }
#pragma unroll 4
        for (int sl = 0; sl < 16; ++sl) { const float* pr = P.PART + ((size_t)sl * NTS + (m - NTP)) * DM + 8 * lane;
#pragma unroll
            for (int j = 0; j < 2; ++j) { va[j] += *(const f32x4*)(pr + 512 * j); vb[j] += *(const f32x4*)(pr + 512 * j + 4); } }
#pragma unroll
        for (int j = 0; j < 2; ++j) s += (va[j].x * va[j].x + va[j].y * va[j].y) + (va[j].z * va[j].z + va[j].w * va[j].w) + (vb[j].x * vb[j].x + vb[j].y * vb[j].y) + (vb[j].z * vb[j].z + vb[j].w * vb[j].w);
        const float r = rsqrtf(wave_sum(s) * (1.f / DM) + EPS);
        float* yo = P.out + (size_t)m * DM + 8 * lane;
#pragma unroll
        for (int j = 0; j < 2; ++j) { *(f32x4*)(yo + 512 * j) = va[j] * r * ga[j]; *(f32x4*)(yo + 512 * j + 4) = vb[j] * r * gb[j]; }
    }
}

#define XB_TMO      128
#define XB_XCNT(j)  (256  + 64 * (j))
#define XB_XSUB(j)  (1280 + 64 * (j))
#define XB_XGEN(j)  (2304 + 64 * (j))
#define XB_TOP      3328
#define XB_TOPGEN   3392
#define XCD_BAR_WORDS 3456
#define XB_SPIN_CAP (1u << 18)
DI unsigned xb_ld(unsigned* p)              { return __hip_atomic_load(p, __ATOMIC_RELAXED, __HIP_MEMORY_SCOPE_AGENT); }
DI unsigned xb_add(unsigned* p, unsigned v) { return __hip_atomic_fetch_add(p, v, __ATOMIC_RELAXED, __HIP_MEMORY_SCOPE_AGENT); }
DI unsigned xb_xcc_id() { return (unsigned)__builtin_amdgcn_s_getreg((3 << 11) | 20) & 0xFu; }
#define XB_SPIN(cond, bar) do { unsigned _sp = 0; while (cond) { __builtin_amdgcn_s_sleep(1); \
    if ((++_sp & 255u) == 0u) { if (xb_ld(&(bar)[XB_TMO])) break; if (_sp > XB_SPIN_CAP) { atomicAdd(&(bar)[XB_TMO], 1u); break; } } } } while (0)
struct XcdBarrier { unsigned* bar; unsigned x; volatile LAS unsigned* st; };
DI XcdBarrier xcd_barrier_post(unsigned* bar, volatile LAS unsigned* st) {
    XcdBarrier b; b.bar = bar; b.x = xb_xcc_id(); b.st = st;
    if (threadIdx.x == 0) (void)xb_add(&bar[XB_XCNT(b.x)], 1u);
    return b;
}
DI void xcd_barrier_complete(unsigned* bar, unsigned x, unsigned& nloc, unsigned& nx) {
    const unsigned G = gridDim.x * gridDim.y * gridDim.z;
    unsigned sum, cnt, mine, sp = 0u;
    for (;;) {
        sum = 0u; cnt = 0u; mine = 0u;
#pragma unroll
        for (unsigned j = 0; j < 16; ++j) { const unsigned c = xb_ld(&bar[XB_XCNT(j)]); sum += c; cnt += (c > 0u) ? 1u : 0u; mine = (j == x) ? c : mine; }
        if (sum == G) break;
        __builtin_amdgcn_s_sleep(1);
        if ((++sp & 255u) == 0u) { if (xb_ld(&bar[XB_TMO])) break; if (sp > XB_SPIN_CAP) { atomicAdd(&bar[XB_TMO], 1u); break; } }
    }
    nloc = mine > 0u ? mine : 1u; nx = cnt > 0u ? cnt : 1u;
}
DI void xcd_barrier(const XcdBarrier& b) {
    asm volatile("s_waitcnt vmcnt(0)" ::: "memory");
    __syncthreads();
    if (threadIdx.x == 0) {
        unsigned* bar = b.bar;
        __builtin_amdgcn_s_waitcnt(0);
        unsigned nloc = b.st[0], nx = b.st[1];
        if (nloc == 0u) { xcd_barrier_complete(bar, b.x, nloc, nx); b.st[0] = nloc; b.st[1] = nx; }
        const unsigned old = xb_add(&bar[XB_XSUB(b.x)], 1u);
        const unsigned gen = old / nloc;
        if (old + 1u == (gen + 1u) * nloc) {
            __builtin_amdgcn_fence(__ATOMIC_RELEASE, "agent");
            asm volatile("s_waitcnt vmcnt(0)" ::: "memory");
            const unsigned og = xb_add(&bar[XB_TOP], 1u);
            const unsigned tg = og / nx;
            if (og + 1u == (tg + 1u) * nx) xb_add(&bar[XB_TOPGEN], 1u);
            else XB_SPIN(xb_ld(&bar[XB_TOPGEN]) == tg, bar);
            __builtin_amdgcn_fence(__ATOMIC_ACQUIRE, "agent");
            xb_add(&bar[XB_XGEN(b.x)], 1u);
            asm volatile("s_waitcnt vmcnt(0)" ::: "memory");
        } else {
            XB_SPIN(xb_ld(&bar[XB_XGEN(b.x)]) == gen, bar);
            __builtin_amdgcn_fence(__ATOMIC_ACQUIRE, "agent");
            asm volatile("s_waitcnt vmcnt(0)" ::: "memory");
        }
    }
    __syncthreads();
}

struct Args { const float* in[15]; float* out; unsigned char* ws; int ph_lo, ph_hi; };
constexpr int NPHASE = 9;

__global__ void __launch_bounds__(512, 2) mk_fwd(Args args) {
    extern __shared__ __attribute__((aligned(16))) unsigned char lds_raw[];
    LAS unsigned char* lds = (LAS unsigned char*)lds_raw;
    cg::grid_group grid = cg::this_grid();
    const int G = gridDim.x;
    Ptrs P;
    P.x_p = args.in[0]; P.x_s = args.in[1]; P.state = args.in[2]; P.ck = args.in[3]; P.cv = args.in[4]; P.ln_mix = args.in[5]; P.w_in = args.in[6]; P.lb_logits = args.in[7];
    P.hg_norm = args.in[8]; P.sinks = args.in[9]; P.w_out = args.in[10]; P.ln_mlp = args.in[11]; P.w_up = args.in[12]; P.w_down = args.in[13]; P.ln_final = args.in[14];
    P.out = args.out;
    unsigned char* ws = args.ws;
    P.WinT = (bf16_t*)(ws + WS_WIN); P.WoutT = (bf16_t*)(ws + WS_WOUT); P.WupT = (bf16_t*)(ws + WS_WUP); P.WdnT = (bf16_t*)(ws + WS_WDN);
    P.XN = (bf16_t*)(ws + WS_XN); P.Z = (bf16_t*)(ws + WS_Z); P.MIX = (bf16_t*)(ws + WS_MIX); P.U = (bf16_t*)(ws + WS_U);
    P.HS = (float*)(ws + WS_HS); P.DSC = (float*)(ws + WS_DSC); P.rss1 = (float*)(ws + WS_RSS1); P.rss2 = (float*)(ws + WS_RSS2); P.PART = (float*)(ws + WS_PART);
    const int lo = args.ph_lo, hi = args.ph_hi;
    unsigned* barw = (unsigned*)(ws + WS_BAR);
    volatile LAS unsigned* misc = (volatile LAS unsigned*)(lds + LDS_MISC);
    if (threadIdx.x < 2) misc[threadIdx.x] = 0u;
    __syncthreads();
    if (hi < 0) grid.sync();
    XcdBarrier xbar = xcd_barrier_post(barw, misc);
#define IN(k) (lo <= (k) && (k) < hi)
#define SEAM(k) do { if (IN(k) && IN((k) + 1)) xcd_barrier(xbar); } while (0)
    if (IN(0)) { p0_prologue(lds, P, G); if (PROBE_P0) { __syncthreads(); p0_prologue(lds, P, G); } }
    SEAM(0);
    if (PROBE_SYNC) { for (int i = 0; i < 8; ++i) grid.sync(); }
    if (IN(1)) { pg8::Gemm g{P.XN, P.WinT, DM, DM / 64}; pg8::StaticOrder S; S.init(M, NIN, G, (int)blockIdx.x); pg8::EpiZ E{P.Z, NIN};
        pg8::gemm_phase<pg8::EpiZ, pg8::StaticOrder, true>(lds, g, S, E); }
    SEAM(1);
    if (IN(2)) {
        for (int rep = 0; rep < 1 + PROBE_P2A; ++rep)
        for (int u = blockIdx.x; u < 1024; u += G) hgrn_unit<false>(lds, P, u);
        for (int rep = 0; rep < 1 + PROBE_P2A; ++rep) {
        for (int u = blockIdx.x; u < 512; u += G) swa_prompt_unit(lds, P, u);
        for (int u = blockIdx.x; u < 512; u += G) hgrn_sample_unit(lds, P, u);
        for (int u = blockIdx.x; u < 128; u += G) swa_sample_unit(lds, P, u); }
    }
    SEAM(2);
    if (IN(3)) {
        { pg8::Gemm g{P.MIX, P.WoutT, DM, DM / 64}; pg8::RectOrder S; S.init(NTP / 256, NTS / 256, DM / 256, 1, DM / 64, G, (int)blockIdx.x); pg8::EpiRes1 E{P.x_p, P.x_s, P.XN, P.rss1};
          pg8::gemm_phase<pg8::EpiRes1, pg8::RectOrder, true>(lds, g, S, E); }
        scan_phase(P, G, G > 32 ? 16 : 0);
    }
    SEAM(3);
    if (IN(4)) { for (int rep = 0; rep < 1 + PROBE_P2C; ++rep) for (int u = blockIdx.x; u < 1024; u += G) hgrn_unit<true>(lds, P, u); }
    SEAM(4);
    if (IN(5)) {
        { pg8::Gemm g{P.MIX, P.WoutT, DM, DM / 64}; pg8::StaticOrder S; S.init(NTP, DM, G, (int)blockIdx.x); pg8::EpiRes1 E{P.x_p, P.x_s, P.XN, P.rss1};
          pg8::gemm_phase<pg8::EpiRes1, pg8::StaticOrder, true>(lds, g, S, E); }
        { pg8::Gemm g{P.XN, P.WupT, DM, DM / 64}; pg8::RectOrder S; S.init(NTP / 256, NTS / 256, FF / 256, 1, DM / 64, G, (int)blockIdx.x); pg8::EpiUp E{P.U, FF, P.rss1};
          pg8::gemm_phase<pg8::EpiUp, pg8::RectOrder, true>(lds, g, S, E); }
    }
    SEAM(5);
    if (IN(6)) {
        { pg8::Gemm g{P.XN, P.WupT, DM, DM / 64}; pg8::StaticOrder S; S.init(NTP, FF, G, (int)blockIdx.x); pg8::EpiUp E{P.U, FF, P.rss1};
          pg8::gemm_phase<pg8::EpiUp, pg8::StaticOrder, true>(lds, g, S, E); }
        { pg8::Gemm g{P.U, P.WdnT, FF, 4}; pg8::RectOrder S; S.init(NTP / 256, NTS / 256, DM / 256, 16, 4, G, (int)blockIdx.x); pg8::EpiDown<true> E{P.XN, P.PART};
          pg8::gemm_phase<pg8::EpiDown<true>, pg8::RectOrder, true, true>(lds, g, S, E); }
    }
    SEAM(6);
    if (IN(7)) { pg8::Gemm g{P.U, P.WdnT, FF, FF / 64}; pg8::StaticOrder S; S.init(NTP, DM, G, (int)blockIdx.x); pg8::EpiDown<false> E{P.XN, nullptr};
        pg8::gemm_phase<pg8::EpiDown<false>, pg8::StaticOrder, true>(lds, g, S, E); }
    SEAM(7);
    if (IN(8)) { final_norm(P, G); }
#undef IN
#undef SEAM
}

extern "C" void kernel_launch(void* const* d_in, const int* in_sizes, int n_in, void* d_out, int out_size, void* d_ws, size_t ws_size, hipStream_t stream) {
    static int grid = 0;
    if (grid == 0) {
        if (n_in != 15 || (size_t)out_size != O_END || ws_size < WS_END) { fprintf(stderr, "kernel_launch: unexpected shapes (n_in %d out %d ws %zu)\n", n_in, out_size, ws_size); grid = -1; return; }
        int dev = 0, cus = 0, per_cu = 0;
        (void)hipGetDevice(&dev); (void)hipDeviceGetAttribute(&cus, hipDeviceAttributeMultiprocessorCount, dev);
        if (hipFuncSetAttribute((const void*)mk_fwd, hipFuncAttributeMaxDynamicSharedMemorySize, LDS_BYTES) != hipSuccess) { fprintf(stderr, "kernel_launch: hipFuncSetAttribute failed\n"); grid = -1; return; }
        if (hipOccupancyMaxActiveBlocksPerMultiprocessor(&per_cu, (const void*)mk_fwd, 512, LDS_BYTES) != hipSuccess || per_cu < 1) { fprintf(stderr, "kernel_launch: occupancy query says %d\n", per_cu); per_cu = 1; }
        (void)hipGetLastError();
        if (per_cu > 1) per_cu = 1;
        grid = cus * per_cu;
    }
    if (grid < 0) return;
    if (hipMemsetAsync((char*)d_ws + WS_BAR, 0, 16384, stream) != hipSuccess) { fprintf(stderr, "kernel_launch: memset of the barrier words failed\n"); return; }
    Args a{};
    for (int i = 0; i < 15; ++i) a.in[i] = (const float*)d_in[i];
    a.out = (float*)d_out; a.ws = (unsigned char*)d_ws;
#if MK_COOP
    a.ph_lo = 0; a.ph_hi = NPHASE;
    void* kargs[] = {&a};
    hipError_t e = hipLaunchCooperativeKernel((const void*)mk_fwd, dim3(grid), dim3(512), kargs, LDS_BYTES, stream);
    if (e != hipSuccess) fprintf(stderr, "cooperative launch failed: %s (grid %d)\n", hipGetErrorString(e), grid);
#else
    for (int p = 0; p < NPHASE; ++p) { a.ph_lo = p; a.ph_hi = p + 1; hipLaunchKernelGGL(mk_fwd, dim3(grid), dim3(512), LDS_BYTES, stream, a); }
#endif
}
```

```cpp
#include <hip/hip_runtime.h>
#include <hip/hip_cooperative_groups.h>
#include <cstdio>
#include <cstdint>
namespace cg = cooperative_groups;

#ifndef MK_COOP
#define MK_COOP 1
#endif
#define PROBE_P0 0
#define PROBE_P3 0
#define PROBE_P2A 0
#define PROBE_P2C 0
#define PROBE_SYNC 0

#define DI __device__ __forceinline__
#define LAS __attribute__((address_space(3)))
typedef unsigned short bf16_t;
typedef short bf16x8 __attribute__((ext_vector_type(8)));
typedef short s16x4 __attribute__((ext_vector_type(4)));
typedef float f32x4 __attribute__((ext_vector_type(4)));
typedef float f32x16 __attribute__((ext_vector_type(16)));
typedef unsigned u32x4 __attribute__((ext_vector_type(4)));
typedef unsigned u32x2 __attribute__((ext_vector_type(2)));
typedef float f32x2_t __attribute__((ext_vector_type(2)));
typedef __bf16 bf16x2_t __attribute__((ext_vector_type(2)));

DI unsigned pk2(float lo, float hi) { f32x2_t v = {lo, hi}; bf16x2_t b = __builtin_convertvector(v, bf16x2_t); return __builtin_bit_cast(unsigned, b); }
DI float bf2f(bf16_t v) { return __uint_as_float(((unsigned)v) << 16); }
DI float bflo(unsigned w) { return __uint_as_float(w << 16); }
DI float bfhi(unsigned w) { return __uint_as_float(w & 0xffff0000u); }
DI int crow(int reg, int h) { return (reg & 3) + 8 * (reg >> 2) + 4 * h; }
#define MFMA32(a, b, c) __builtin_amdgcn_mfma_f32_32x32x16_bf16((a), (b), (c), 0, 0, 0)
DI bf16x8 packs(const f32x16& x, int s) {
    u32x4 p; p.x = pk2(x[8 * s], x[8 * s + 1]); p.y = pk2(x[8 * s + 2], x[8 * s + 3]); p.z = pk2(x[8 * s + 4], x[8 * s + 5]); p.w = pk2(x[8 * s + 6], x[8 * s + 7]);
    return __builtin_bit_cast(bf16x8, p);
}
DI bf16x8 cat4(s16x4 lo, s16x4 hi) { return __builtin_shufflevector(lo, hi, 0, 1, 2, 3, 4, 5, 6, 7); }
DI float wave_sum(float v) {
#pragma unroll
    for (int o = 1; o < 64; o <<= 1) v += __shfl_xor(v, o);
    return v;
}

constexpr int DM = 1024, SEQ = 4096, NB = 8, NTP = NB * SEQ, DB = 128, DS = 8, NTS = DB * DS, M = NTP + NTS;
constexpr int NIN = 2816, FF = 4096;
constexpr int ZQ = 0, ZF = 512, ZI = 1024, ZG = 1536, ZSQ = 2048, ZSK = 2560, ZSV = 2688;
constexpr float EPS = 1e-6f;
constexpr size_t O_Y = 0, O_SP = (size_t)M * DM, O_KP = O_SP + 8 * 4 * 128 * 128, O_VP = O_KP + 8 * 128 * 128, O_SS = O_VP + 8 * 128 * 128,
                 O_KS = O_SS + (size_t)128 * 4 * 128 * 128, O_VS = O_KS + (size_t)128 * 128 * 128, O_END = O_VS + (size_t)128 * 128 * 128;
constexpr size_t MiB = 1u << 20;
constexpr size_t WS_RSS1 = 0, WS_RSS2 = 256 * 1024, WS_BAR = 512 * 1024, WS_WIN = 1 * MiB, WS_WOUT = 7 * MiB, WS_WUP = 9 * MiB, WS_WDN = 17 * MiB, WS_DSC = 25 * MiB,
                 WS_XN = 26 * MiB, WS_Z = 92 * MiB, WS_MIX = 274 * MiB, WS_HS = 340 * MiB, WS_U = 92 * MiB, WS_PART = 404 * MiB, WS_END = 468 * MiB;
static_assert(WS_XN + (size_t)M * DM * 2 <= WS_Z && WS_Z + (size_t)M * NIN * 2 <= WS_MIX && WS_MIX + (size_t)M * DM * 2 <= WS_HS && WS_U + (size_t)M * FF * 2 <= WS_END, "ws map");
constexpr int LDS_BYTES = 155648, LDS_MISC = LDS_BYTES - 64;

namespace pg8 {
constexpr int BM = 256, BK = 64, HALF = 128, HTB = HALF * BK * 2, STAGE_BYTES = 8 * HTB, NXCD = 8, WGM = 8;
DI int lds_byte(int r, int c) { const int st = (r >> 4) * 2 + (c >> 5), rr = r & 15, cc = c & 31, ob = rr * 64 + cc * 2; return st * 1024 + (ob ^ (((ob >> 9) & 1) << 5)); }
DI void stage_rc(int b, int& R, int& C) { const int st = b / 1024, sb = b % 1024, swz = sb ^ (((sb >> 9) & 1) << 5); R = (st >> 1) * 16 + swz / 64; C = (st & 1) * 32 + (swz % 64) / 2; }
DI int perm32(int rho) { const int n = rho >> 4, i = rho & 15; return 8 * (i >> 2) + 4 * n + (i & 3); }
struct Unit { int pm, pn, kt0; };
struct Gemm { const bf16_t* A; const bf16_t* Bt; int K, nt; };
struct StaticOrder {
    int nM, nN, nwg, G, c;
    DI void init(int M_, int N_, int G_, int c_) { nM = M_ / BM; nN = N_ / BM; nwg = nM * nN; G = G_; c = c_; }
    DI bool next(int i, Unit& u) const {
        const long L = (long)i * G + c; if (L >= nwg) return false;
        int wgid = (int)L; { const int q = nwg / NXCD, r = nwg % NXCD, xcd = wgid % NXCD, off = wgid / NXCD; wgid = (xcd < r ? xcd * (q + 1) : r * (q + 1) + (xcd - r) * q) + off; }
        const int nig = WGM * nN, gid = wgid / nig, fm = gid * WGM, gsz = (nM - fm) < WGM ? (nM - fm) : WGM;
        u.pm = fm + ((wgid % nig) % gsz); u.pn = (wgid % nig) / gsz; u.kt0 = 0; return true;
    }
};
struct RectOrder {
    int pm0, nN, nslice, nt, total, G, c;
    DI void init(int pm0_, int nPm, int nN_, int nslice_, int nt_, int G_, int c_) { pm0 = pm0_; nN = nN_; nslice = nslice_; nt = nt_; total = nPm * nN_ * nslice_; G = G_; c = c_; }
    DI bool next(int i, Unit& u) const {
        const long L = (long)i * G + c; if (L >= total) return false;
        const int sl = (int)L % nslice, t = (int)L / nslice; u.pn = t % nN; u.pm = pm0 + t / nN; u.kt0 = sl * nt; return true;
    }
};
struct EpiZ {
    static constexpr bool PERM = true;
    bf16_t* O; int ldc; const float* rstd;
    DI void operator()(const f32x4 (&acc)[2][2][4][2], const Unit& u, int wr, int wc, int fr, int fq) const {
        const int row0 = u.pm * BM + wr * 64 + fr, col0 = u.pn * BM + wc * 32 + 8 * fq;
        float rsv[2][4];
#pragma unroll
        for (int ai = 0; ai < 2; ++ai)
#pragma unroll
            for (int m = 0; m < 4; ++m) rsv[ai][m] = rstd[row0 + ai * HALF + m * 16];
        asm volatile("" ::: "memory");
#pragma unroll
        for (int ai = 0; ai < 2; ++ai)
#pragma unroll
            for (int m = 0; m < 4; ++m) { bf16_t* rowp = O + (size_t)(row0 + ai * HALF + m * 16) * ldc + col0;
#pragma unroll
                for (int bj = 0; bj < 2; ++bj) { const f32x4 v0 = acc[ai][bj][m][0] * rsv[ai][m], v1 = acc[ai][bj][m][1] * rsv[ai][m];
                    u32x4 w; w.x = pk2(v0[0], v0[1]); w.y = pk2(v0[2], v0[3]); w.z = pk2(v1[0], v1[1]); w.w = pk2(v1[2], v1[3]);
                    *(u32x4*)(rowp + bj * HALF) = w; } }
    }
};
struct EpiUp {
    static constexpr bool PERM = true;
    bf16_t* O; int ldc; const float* rowss;
    DI void operator()(const f32x4 (&acc)[2][2][4][2], const Unit& u, int wr, int wc, int fr, int fq) const {
        const int row0 = u.pm * BM + wr * 64 + fr, col0 = u.pn * BM + wc * 32 + 8 * fq;
        float rsv[2][4];
#pragma unroll
        for (int ai = 0; ai < 2; ++ai)
#pragma unroll
            for (int m = 0; m < 4; ++m) rsv[ai][m] = rowss[row0 + ai * HALF + m * 16];
        asm volatile("" ::: "memory");
#pragma unroll
        for (int ai = 0; ai < 2; ++ai)
#pragma unroll
            for (int m = 0; m < 4; ++m) { const int r = row0 + ai * HALF + m * 16; bf16_t* rowp = O + (size_t)r * ldc + col0;
                const float rs = rsqrtf(rsv[ai][m] * (1.0f / DM) + EPS);
#pragma unroll
                for (int bj = 0; bj < 2; ++bj) { f32x4 v0 = acc[ai][bj][m][0] * rs, v1 = acc[ai][bj][m][1] * rs;
#pragma unroll
                    for (int j = 0; j < 4; ++j) { const float a = fmaxf(v0[j], 0.f), b = fmaxf(v1[j], 0.f); v0[j] = a * a; v1[j] = b * b; }
                    u32x4 w; w.x = pk2(v0[0], v0[1]); w.y = pk2(v0[2], v0[3]); w.z = pk2(v1[0], v1[1]); w.w = pk2(v1[2], v1[3]);
                    *(u32x4*)(rowp + bj * HALF) = w; } }
    }
};
struct EpiRes1 {
    static constexpr bool PERM = false;
    bf16_t* hb; float* rowss;
    DI void operator()(const f32x4 (&acc)[2][2][4][2], const Unit& u, int wr, int wc, int fr, int fq) const {
        const int col0 = u.pn * BM + wc * 32 + 4 * fq;
        u32x2 xw[2][4][2][2];
#pragma unroll
        for (int ai = 0; ai < 2; ++ai)
#pragma unroll
            for (int m = 0; m < 4; ++m) { const bf16_t* hrow = hb + (size_t)(u.pm * BM + ai * HALF + wr * 64 + m * 16 + fr) * DM + col0;
#pragma unroll
                for (int bj = 0; bj < 2; ++bj)
#pragma unroll
                    for (int n = 0; n < 2; ++n) xw[ai][m][bj][n] = *(const u32x2*)(hrow + bj * HALF + n * 16); }
        asm volatile("" ::: "memory");
#pragma unroll
        for (int ai = 0; ai < 2; ++ai)
#pragma unroll
            for (int m = 0; m < 4; ++m) { const int r = u.pm * BM + ai * HALF + wr * 64 + m * 16 + fr; bf16_t* hrow = hb + (size_t)r * DM + col0; float ss = 0.f;
#pragma unroll
                for (int bj = 0; bj < 2; ++bj)
#pragma unroll
                    for (int n = 0; n < 2; ++n) { const u32x2 x2 = xw[ai][m][bj][n]; const f32x4 a = acc[ai][bj][m][n];
                        const float o0 = bflo(x2.x) + a[0], o1 = bfhi(x2.x) + a[1], o2 = bflo(x2.y) + a[2], o3 = bfhi(x2.y) + a[3];
                        ss += (o0 * o0 + o1 * o1) + (o2 * o2 + o3 * o3);
                        u32x2 w; w.x = pk2(o0, o1); w.y = pk2(o2, o3); *(u32x2*)(hrow + bj * HALF + n * 16) = w; }
                ss += __shfl_xor(ss, 16); ss += __shfl_xor(ss, 32);
                if (fq == 0) unsafeAtomicAdd(rowss + r, ss); }
    }
};
template <bool PARTIAL> struct EpiDown {
    static constexpr bool PERM = false;
    bf16_t* hb; float* part;
    DI void operator()(const f32x4 (&acc)[2][2][4][2], const Unit& u, int wr, int wc, int fr, int fq) const {
        const int col0 = u.pn * BM + wc * 32 + 4 * fq;
        if (PARTIAL) {
#pragma unroll
            for (int ai = 0; ai < 2; ++ai)
#pragma unroll
                for (int m = 0; m < 4; ++m) { const int r = u.pm * BM + ai * HALF + wr * 64 + m * 16 + fr;
                    float* prow = part + ((size_t)(u.kt0 >> 2) * NTS + (size_t)(r - NTP)) * DM;
#pragma unroll
                    for (int bj = 0; bj < 2; ++bj)
#pragma unroll
                        for (int n = 0; n < 2; ++n) *(f32x4*)(prow + col0 + bj * HALF + n * 16) = acc[ai][bj][m][n]; }
        } else {
            u32x2 hw[2][4][2][2];
#pragma unroll
            for (int ai = 0; ai < 2; ++ai)
#pragma unroll
                for (int m = 0; m < 4; ++m) { const bf16_t* hrow = hb + (size_t)(u.pm * BM + ai * HALF + wr * 64 + m * 16 + fr) * DM + col0;
#pragma unroll
                    for (int bj = 0; bj < 2; ++bj)
#pragma unroll
                        for (int n = 0; n < 2; ++n) hw[ai][m][bj][n] = *(const u32x2*)(hrow + bj * HALF + n * 16); }
            asm volatile("" ::: "memory");
#pragma unroll
            for (int ai = 0; ai < 2; ++ai)
#pragma unroll
                for (int m = 0; m < 4; ++m) { bf16_t* hrow = hb + (size_t)(u.pm * BM + ai * HALF + wr * 64 + m * 16 + fr) * DM + col0;
#pragma unroll
                    for (int bj = 0; bj < 2; ++bj)
#pragma unroll
                        for (int n = 0; n < 2; ++n) { const u32x2 h2 = hw[ai][m][bj][n]; const f32x4 a = acc[ai][bj][m][n];
                            u32x2 w; w.x = pk2(bflo(h2.x) + a[0], bfhi(h2.x) + a[1]); w.y = pk2(bflo(h2.y) + a[2], bfhi(h2.y) + a[3]); *(u32x2*)(hrow + bj * HALF + n * 16) = w; } }
        }
    }
};

template <class Epi, class Sched, bool ALIGN_EPI = true, bool OPAQUE_NT = false>
DI void gemm_phase(LAS unsigned char* lds, const Gemm g, const Sched& S, const Epi& E) {
    const int tid = threadIdx.x, wid = __builtin_amdgcn_readfirstlane(tid >> 6), lane = tid & 63, wr = wid >> 2, wc = wid & 3, fr = lane & 15, fq = lane >> 4;
    const int K = g.K; int nt = g.nt; if (OPAQUE_NT) asm volatile("" : "+s"(nt));
    unsigned voffA[2], voffB[2];
#pragma unroll
    for (int i = 0; i < 2; ++i) { int R, C; stage_rc(tid * 16 + i * 8192, R, C); const int Rb = Epi::PERM ? ((R & ~31) + perm32(R & 31)) : R;
        voffA[i] = (unsigned)(R * K + C) * 2u; voffB[i] = (unsigned)(Rb * K + C) * 2u; }
    const size_t kstep = (size_t)(BK * 2);
    const size_t hstep = (size_t)HALF * K * 2;
    const size_t tstep = 2 * hstep;
    const unsigned ldsw = (unsigned)wid * 1024u;
    const int aoff = lds_byte(wr * 64 + fr, fq * 8), boff = lds_byte(wc * 32 + fr, fq * 8);
#define PG8_SA(b, h) (((b) * 2 + (h)) * HTB)
#define PG8_SB(b, h) ((4 + (b) * 2 + (h)) * HTB)
#define PG8_STAGE(bufoff, gbase, voff) do { _Pragma("unroll") for (int _i = 0; _i < 2; ++_i) \
        __builtin_amdgcn_global_load_lds((const unsigned*)((const char*)(gbase) + (voff)[_i]), (LAS unsigned*)(lds + (bufoff) + ldsw + _i * 8192), 16, 0, 0); } while (0)
#define PG8_LDA(dst, b, h) do { _Pragma("unroll") for (int m = 0; m < 4; ++m) _Pragma("unroll") for (int k = 0; k < 2; ++k) dst[m][k] = *(const LAS bf16x8*)(lds + PG8_SA(b, h) + aoff + m * 2048 + k * 1024); } while (0)
#define PG8_LDB(dst, b, h) do { _Pragma("unroll") for (int n = 0; n < 2; ++n) _Pragma("unroll") for (int k = 0; k < 2; ++k) dst[n][k] = *(const LAS bf16x8*)(lds + PG8_SB(b, h) + boff + n * 2048 + k * 1024); } while (0)
#define PG8_MMA(ai, bj, At, Bt) do { __builtin_amdgcn_s_setprio(1); _Pragma("unroll") for (int m = 0; m < 4; ++m) _Pragma("unroll") for (int n = 0; n < 2; ++n) _Pragma("unroll") for (int k = 0; k < 2; ++k) \
        acc[ai][bj][m][n] = __builtin_amdgcn_mfma_f32_16x16x32_bf16(Bt[n][k], At[m][k], acc[ai][bj][m][n], 0, 0, 0); __builtin_amdgcn_s_setprio(0); } while (0)
#define PG8_WAIT_V(n) asm volatile("s_waitcnt vmcnt(" #n ")" ::: "memory")
#define PG8_WAIT_L(n) asm volatile("s_waitcnt lgkmcnt(" #n ")" ::: "memory")
#define PG8_BAR __builtin_amdgcn_s_barrier()
#define PG8_SCHED __builtin_amdgcn_sched_barrier(0)
    Unit cur, nxt; int ui = 0;
    if (!S.next(0, cur)) return;
    f32x4 acc[2][2][4][2];
#pragma unroll
    for (int a = 0; a < 2; ++a)
#pragma unroll
        for (int b = 0; b < 2; ++b)
#pragma unroll
            for (int m = 0; m < 4; ++m)
#pragma unroll
                for (int n = 0; n < 2; ++n) acc[a][b][m][n] = (f32x4){0.f, 0.f, 0.f, 0.f};
    bf16x8 At[4][2], B0[2][2], B1[2][2];
    const char* cA = (const char*)g.A + (size_t)cur.pm * tstep + (size_t)cur.kt0 * kstep; const char* cB = (const char*)g.Bt + (size_t)cur.pn * tstep + (size_t)cur.kt0 * kstep;
    PG8_STAGE(PG8_SB(0, 0), cB, voffB); PG8_STAGE(PG8_SB(0, 1), cB + hstep, voffB); PG8_STAGE(PG8_SA(0, 0), cA, voffA); PG8_STAGE(PG8_SA(0, 1), cA + hstep, voffA);
    if (wr == 1) PG8_BAR;
    PG8_WAIT_V(2); PG8_BAR;
    PG8_STAGE(PG8_SB(1, 0), cB + kstep, voffB); PG8_STAGE(PG8_SA(1, 0), cA + kstep, voffA); PG8_STAGE(PG8_SB(1, 1), cB + hstep + kstep, voffB);
    PG8_WAIT_V(6); PG8_BAR;
    for (;;) {
        const bool has_next = S.next(ui + 1, nxt);
        const char* nA = has_next ? (const char*)g.A + (size_t)nxt.pm * tstep + (size_t)nxt.kt0 * kstep : cA; const char* nB = has_next ? (const char*)g.Bt + (size_t)nxt.pn * tstep + (size_t)nxt.kt0 * kstep : cB;
        for (int t = 0; t < nt; t += 2) {
            const bool last = (t == nt - 2);
            const char* a1 = cA + (size_t)(t + 1) * kstep;
            const char* a2 = last ? nA : cA + (size_t)(t + 2) * kstep; const char* b2 = last ? nB : cB + (size_t)(t + 2) * kstep;
            const char* a3 = a2 + kstep; const char* b3 = b2 + kstep;
            PG8_LDB(B0, 0, 0); PG8_LDB(B1, 0, 1); PG8_SCHED; PG8_LDA(At, 0, 0); PG8_STAGE(PG8_SA(1, 1), a1 + hstep, voffA);
            PG8_WAIT_V(8); PG8_WAIT_L(0); PG8_BAR; PG8_MMA(0, 0, At, B0); PG8_MMA(0, 1, At, B1); PG8_BAR; PG8_SCHED;
            PG8_LDA(At, 0, 1); PG8_STAGE(PG8_SB(0, 0), b2, voffB); PG8_STAGE(PG8_SB(0, 1), b2 + hstep, voffB); PG8_STAGE(PG8_SA(0, 0), a2, voffA);
            PG8_WAIT_V(8); PG8_WAIT_L(0); PG8_BAR; PG8_MMA(1, 0, At, B0); PG8_MMA(1, 1, At, B1); PG8_BAR; PG8_SCHED;
            PG8_LDB(B0, 1, 0); PG8_LDB(B1, 1, 1); PG8_SCHED; PG8_LDA(At, 1, 0); PG8_STAGE(PG8_SA(0, 1), a2 + hstep, voffA);
            PG8_WAIT_V(8); PG8_WAIT_L(0); PG8_BAR; PG8_MMA(0, 0, At, B0); PG8_MMA(0, 1, At, B1); PG8_BAR; PG8_SCHED;
            PG8_LDA(At, 1, 1); PG8_STAGE(PG8_SB(1, 0), b3, voffB); PG8_STAGE(PG8_SB(1, 1), b3 + hstep, voffB); PG8_STAGE(PG8_SA(1, 0), a3, voffA);
            PG8_WAIT_V(8); PG8_WAIT_L(0); PG8_BAR; PG8_MMA(1, 0, At, B0); PG8_MMA(1, 1, At, B1); PG8_BAR; PG8_SCHED;
        }
        if constexpr (ALIGN_EPI) { if (wr == 0) PG8_BAR; }
        E(acc, cur, wr, wc, fr, fq);
        if (!has_next) break;
#pragma unroll
        for (int a = 0; a < 2; ++a)
#pragma unroll
            for (int b = 0; b < 2; ++b)
#pragma unroll
                for (int m = 0; m < 4; ++m)
#pragma unroll
                    for (int n = 0; n < 2; ++n) acc[a][b][m][n] = (f32x4){0.f, 0.f, 0.f, 0.f};
        cur = nxt; cA = nA; cB = nB; ++ui;
        if constexpr (ALIGN_EPI) { if (wr == 1) PG8_BAR; }
    }
    PG8_WAIT_V(0);
    if constexpr (!ALIGN_EPI) { if (wr == 0) PG8_BAR; }
    PG8_BAR;
#undef PG8_SA
#undef PG8_SB
#undef PG8_STAGE
#undef PG8_LDA
#undef PG8_LDB
#undef PG8_MMA
#undef PG8_WAIT_V
#undef PG8_WAIT_L
#undef PG8_BAR
#undef PG8_SCHED
}
}

struct Ptrs {
    const float *x_p, *x_s, *state, *ck, *cv, *ln_mix, *w_in, *lb_logits, *hg_norm, *sinks, *w_out, *ln_mlp, *w_up, *w_down, *ln_final;
    float* out;
    bf16_t *WinT, *WoutT, *WupT, *WdnT, *XN, *Z, *MIX, *U;
    bf16_t* HS; float *DSC, *rss1, *rss2, *PART;
};

DI void p0_transpose_item(const float* W, int K, int N, bf16_t* WT, const float* kscale, LAS float* scr, int item, int lane) {
    const int nblk = N / 32, kb = item / nblk, nb = item % nblk, k0 = 64 * kb, n0 = 32 * nb;
    float wv[32];
#pragma unroll
    for (int i = 0; i < 32; ++i) wv[i] = W[(size_t)(k0 + 2 * i + (lane >> 5)) * N + n0 + (lane & 31)];
#pragma unroll
    for (int i = 0; i < 32; ++i) { const int kk = 2 * i + (lane >> 5); float v = wv[i]; if (kscale) v *= kscale[k0 + kk]; scr[kk * 33 + (lane & 31)] = v; }
    asm volatile("s_waitcnt lgkmcnt(0)" ::: "memory");
    const int c = lane & 7;
#pragma unroll
    for (int j = 0; j < 4; ++j) { const int n = (lane >> 3) + 8 * j; const LAS float* s = scr + (8 * c) * 33 + n;
        u32x4 o; o.x = pk2(s[0 * 33], s[1 * 33]); o.y = pk2(s[2 * 33], s[3 * 33]); o.z = pk2(s[4 * 33], s[5 * 33]); o.w = pk2(s[6 * 33], s[7 * 33]);
        *(u32x4*)(WT + (size_t)(n0 + n) * K + k0 + 8 * c) = o; }
    asm volatile("s_waitcnt lgkmcnt(0)" ::: "memory");
}
DI void p0_prologue(LAS unsigned char* lds, const Ptrs& P, int G) {
    const int tid = threadIdx.x, lane = tid & 63, wave = __builtin_amdgcn_readfirstlane(tid >> 6);
    LAS float* scr = (LAS float*)(lds + wave * 16384);
    const int gw = blockIdx.x * 8 + wave, NGW = G * 8;
    constexpr int I_IN = (DM / 64) * (NIN / 32), I_O = (DM / 64) * (DM / 32), I_UP = (DM / 64) * (FF / 32), I_DN = (FF / 64) * (DM / 32);
    constexpr int NITEMS = I_IN + I_O + I_UP + I_DN;
    for (int it = gw; it < NITEMS; it += NGW) {
        int r = it;
        if (r < I_IN) { p0_transpose_item(P.w_in, DM, NIN, P.WinT, P.ln_mix, scr, r, lane); continue; } r -= I_IN;
        if (r < I_O) { p0_transpose_item(P.w_out, DM, DM, P.WoutT, nullptr, scr, r, lane); continue; } r -= I_O;
        if (r < I_UP) { p0_transpose_item(P.w_up, DM, FF, P.WupT, P.ln_mlp, scr, r, lane); continue; } r -= I_UP;
        p0_transpose_item(P.w_down, FF, DM, P.WdnT, nullptr, scr, r, lane);
    }
    for (int m0 = gw; m0 < M; m0 += 2 * NGW) {
        const int m1 = m0 + NGW; const bool has1 = m1 < M; const int mm1 = has1 ? m1 : m0;
        const f32x4* xr0 = (const f32x4*)(m0 < NTP ? P.x_p + (size_t)m0 * DM : P.x_s + (size_t)(m0 - NTP) * DM) + lane;
        const f32x4* xr1 = (const f32x4*)(mm1 < NTP ? P.x_p + (size_t)mm1 * DM : P.x_s + (size_t)(mm1 - NTP) * DM) + lane;
        f32x4 v0[4], v1[4]; float s0 = 0.f, s1 = 0.f;
#pragma unroll
        for (int j = 0; j < 4; ++j) { v0[j] = xr0[64 * j]; v1[j] = xr1[64 * j]; }
#pragma unroll
        for (int j = 0; j < 4; ++j) { s0 += (v0[j].x * v0[j].x + v0[j].y * v0[j].y) + (v0[j].z * v0[j].z + v0[j].w * v0[j].w); s1 += (v1[j].x * v1[j].x + v1[j].y * v1[j].y) + (v1[j].z * v1[j].z + v1[j].w * v1[j].w); }
        const float r0 = rsqrtf(wave_sum(s0) * (1.f / DM) + EPS), r1 = rsqrtf(wave_sum(s1) * (1.f / DM) + EPS);
        unsigned long long* o0 = (unsigned long long*)(P.XN + (size_t)m0 * DM) + lane; unsigned long long* o1 = (unsigned long long*)(P.XN + (size_t)mm1 * DM) + lane;
#pragma unroll
        for (int j = 0; j < 4; ++j) o0[64 * j] = (unsigned long long)pk2(v0[j].x, v0[j].y) | ((unsigned long long)pk2(v0[j].z, v0[j].w) << 32);
        if (lane == 0) P.rss2[m0] = r0;
        if (has1) {
#pragma unroll
            for (int j = 0; j < 4; ++j) o1[64 * j] = (unsigned long long)pk2(v1[j].x, v1[j].y) | ((unsigned long long)pk2(v1[j].z, v1[j].w) << 32);
            if (lane == 0) P.rss2[m1] = r1;
        }
    }
    for (int i = blockIdx.x * 512 + tid; i < M; i += G * 512) P.rss1[i] = 0.f;
}

constexpr int HSTR = 136, HROWB = HSTR * 2;
constexpr int OFF_QT = 0, OFF_KT = 128 * HROWB, OFF_KET = 2 * 128 * HROWB, OFF_VT = 3 * 128 * HROWB, OFF_DEC = 4 * 128 * HROWB, OFF_SS = OFF_DEC + 2048, OFF_AT = OFF_SS + 2048;
static_assert(OFF_AT + 8192 <= LDS_MISC, "hgrn lds");
template <bool FULL>
DI void hgrn_unit(LAS unsigned char* lds, const Ptrs& P, int unit) {
    const int tid = threadIdx.x, lane = tid & 63, wid = __builtin_amdgcn_readfirstlane(tid >> 6), r32 = lane & 31, hi = lane >> 5;
    const int bh = unit >> 5, sc = unit & 31, b = bh >> 2, h = bh & 3;
    const size_t row0 = (size_t)b * SEQ + sc * 128;
    LAS float* DEC = (LAS float*)(lds + OFF_DEC);
    LAS float* SSb = (LAS float*)(lds + OFF_SS);
    const bool act = wid < 4; const int vb = wid & 3, dh = wid >> 2;
    bf16_t* HSu = P.HS + (size_t)unit * 16384;
    f32x16 S[4];
    if (FULL) {
#pragma unroll
        for (int i = 0; i < 4; ++i)
#pragma unroll
            for (int r = 0; r < 16; ++r) S[i][r] = 0.f;
        if (act) {
#pragma unroll
            for (int i = 0; i < 4; ++i) { const u32x4* hp = (const u32x4*)(HSu + ((vb * 4 + i) * 64 + lane) * 16); const u32x4 w0 = hp[0], w1 = hp[1];
                S[i][0] = bflo(w0.x); S[i][1] = bfhi(w0.x); S[i][2] = bflo(w0.y); S[i][3] = bfhi(w0.y); S[i][4] = bflo(w0.z); S[i][5] = bfhi(w0.z); S[i][6] = bflo(w0.w); S[i][7] = bfhi(w0.w);
                S[i][8] = bflo(w1.x); S[i][9] = bfhi(w1.x); S[i][10] = bflo(w1.y); S[i][11] = bfhi(w1.y); S[i][12] = bflo(w1.z); S[i][13] = bfhi(w1.z); S[i][14] = bflo(w1.w); S[i][15] = bfhi(w1.w); }
        }
    } else {
#pragma unroll
        for (int i = 0; i < 4; ++i)
#pragma unroll
            for (int r = 0; r < 16; ++r) S[i][r] = 0.f;
    }
    {
        const int c = tid >> 7, d = tid & 127;
        const float l0 = P.lb_logits[h * 128 + d], l1 = P.lb_logits[512 + h * 128 + d];
        const float lbv = 1.f / (1.f + __expf(l1 - l0)), oml = 1.f - lbv;
        const bf16_t* zrow = P.Z + (row0 + c * 32) * NIN + h * 128 + d;
        float ke[32];
        if (FULL) {
            float eb = 1.f;
#pragma unroll
            for (int t = 0; t < 32; ++t) {
                float zf = bf2f(zrow[(size_t)t * NIN + ZF]); zf = fminf(fmaxf(zf, -30.f), 30.f);
                const float e = __expf(-zf), sg = __builtin_amdgcn_rcpf(1.f + e);
                const float f = lbv + oml * sg, k = oml * e * sg;
                eb *= f;
                const float ieb = __builtin_amdgcn_rcpf(eb);
                const float zq = bf2f(zrow[(size_t)t * NIN + ZQ]);
                const float q = zq * __builtin_amdgcn_rcpf(1.f + __expf(-zq));
                const float ktv = k * ieb; ke[t] = ktv;
                *(LAS bf16_t*)(lds + OFF_QT + (c * 32 + t) * HROWB + d * 2) = (bf16_t)(pk2(q * eb, 0.f) & 0xffffu);
                *(LAS bf16_t*)(lds + OFF_KT + (c * 32 + t) * HROWB + d * 2) = (bf16_t)(pk2(ktv, 0.f) & 0xffffu);
            }
            DEC[c * 128 + d] = eb;
#pragma unroll
            for (int t = 0; t < 32; ++t) ke[t] *= eb;
        } else {
            float sp = 1.f;
#pragma unroll
            for (int t = 31; t >= 0; --t) {
                float zf = bf2f(zrow[(size_t)t * NIN + ZF]); zf = fminf(fmaxf(zf, -30.f), 30.f);
                const float e = __expf(-zf), sg = __builtin_amdgcn_rcpf(1.f + e);
                const float f = lbv + oml * sg, k = oml * e * sg;
                ke[t] = k * sp; sp *= f;
            }
            DEC[c * 128 + d] = sp;
        }
#pragma unroll
        for (int t8 = 0; t8 < 4; ++t8) {
            u32x4 w; w.x = pk2(ke[8 * t8 + 0], ke[8 * t8 + 1]); w.y = pk2(ke[8 * t8 + 2], ke[8 * t8 + 3]); w.z = pk2(ke[8 * t8 + 4], ke[8 * t8 + 5]); w.w = pk2(ke[8 * t8 + 6], ke[8 * t8 + 7]);
            *(LAS u32x4*)(lds + OFF_KET + d * HROWB + (c * 32 + 8 * t8) * 2) = w;
        }
#pragma unroll
        for (int t8 = 0; t8 < 4; ++t8) {
            unsigned v[8];
#pragma unroll
            for (int j = 0; j < 8; ++j) v[j] = zrow[(size_t)(8 * t8 + j) * NIN + ZI];
            u32x4 w; w.x = v[0] | (v[1] << 16); w.y = v[2] | (v[3] << 16); w.z = v[4] | (v[5] << 16); w.w = v[6] | (v[7] << 16);
            *(LAS u32x4*)(lds + OFF_VT + d * HROWB + (c * 32 + 8 * t8) * 2) = w;
        }
    }
    __syncthreads();
    if (!FULL) {
#pragma unroll 1
        for (int c = 0; c < 4; ++c) {
#pragma unroll
            for (int ii = 0; ii < 2; ++ii) {
                const int i = 2 * dh + ii;
#pragma unroll
                for (int g4 = 0; g4 < 4; ++g4) { const f32x4 dv = *(const LAS f32x4*)(DEC + c * 128 + 32 * i + 8 * g4 + 4 * hi);
#pragma unroll
                    for (int j = 0; j < 4; ++j) S[ii][4 * g4 + j] *= dv[j]; }
#pragma unroll
                for (int k2 = 0; k2 < 2; ++k2) {
                    const bf16x8 a = *(const LAS bf16x8*)(lds + OFF_KET + (32 * i + r32) * HROWB + (c * 32 + 16 * k2 + 8 * hi) * 2);
                    const bf16x8 bv = *(const LAS bf16x8*)(lds + OFF_VT + (vb * 32 + r32) * HROWB + (c * 32 + 16 * k2 + 8 * hi) * 2);
                    S[ii] = MFMA32(a, bv, S[ii]);
                }
            }
        }
#pragma unroll
        for (int ii = 0; ii < 2; ++ii) { u32x4* hp = (u32x4*)(HSu + ((vb * 4 + 2 * dh + ii) * 64 + lane) * 16);
            u32x4 w0, w1; w0.x = pk2(S[ii][0], S[ii][1]); w0.y = pk2(S[ii][2], S[ii][3]); w0.z = pk2(S[ii][4], S[ii][5]); w0.w = pk2(S[ii][6], S[ii][7]);
            w1.x = pk2(S[ii][8], S[ii][9]); w1.y = pk2(S[ii][10], S[ii][11]); w1.z = pk2(S[ii][12], S[ii][13]); w1.w = pk2(S[ii][14], S[ii][15]);
            hp[0] = w0; hp[1] = w1; }
        if (tid < 128) P.DSC[unit * 128 + tid] = (DEC[tid] * DEC[128 + tid]) * (DEC[256 + tid] * DEC[384 + tid]);
        __syncthreads();
        return;
    }
    if (!act) {
        const int c = wid - 4;
        f32x16 a0, a1;
#pragma unroll
        for (int r = 0; r < 16; ++r) { a0[r] = 0.f; a1[r] = 0.f; }
#pragma unroll
        for (int ks = 0; ks < 8; ks += 2) {
            const bf16x8 ka = *(const LAS bf16x8*)(lds + OFF_KT + (c * 32 + r32) * HROWB + (ks * 16 + 8 * hi) * 2);
            const bf16x8 qa = *(const LAS bf16x8*)(lds + OFF_QT + (c * 32 + r32) * HROWB + (ks * 16 + 8 * hi) * 2);
            const bf16x8 kb = *(const LAS bf16x8*)(lds + OFF_KT + (c * 32 + r32) * HROWB + (ks * 16 + 16 + 8 * hi) * 2);
            const bf16x8 qb = *(const LAS bf16x8*)(lds + OFF_QT + (c * 32 + r32) * HROWB + (ks * 16 + 16 + 8 * hi) * 2);
            a0 = MFMA32(ka, qa, a0); a1 = MFMA32(kb, qb, a1);
        }
#pragma unroll
        for (int r = 0; r < 16; ++r) a0[r] = (crow(r, hi) > r32) ? 0.f : (a0[r] + a1[r]);
#pragma unroll
        for (int s2 = 0; s2 < 2; ++s2) *(LAS bf16x8*)(lds + OFF_AT + ((c * 2 + s2) * 64 + lane) * 16) = packs(a0, s2);
    }
    __syncthreads();
    f32x16 o[4];
    if (act) {
#pragma unroll
        for (int c = 0; c < 4; ++c) {
            f32x16 oa, ob;
#pragma unroll
            for (int r = 0; r < 16; ++r) { oa[r] = 0.f; ob[r] = 0.f; }
#pragma unroll
            for (int s2 = 0; s2 < 2; ++s2) {
                const bf16x8 pa = *(const LAS bf16x8*)(lds + OFF_AT + ((c * 2 + s2) * 64 + lane) * 16);
                const LAS unsigned char* vp = lds + OFF_VT + (vb * 32 + r32) * HROWB + (c * 32 + 16 * s2 + 4 * hi) * 2;
                const bf16x8 av = cat4(*(const LAS s16x4*)vp, *(const LAS s16x4*)(vp + 16));
                oa = MFMA32(av, pa, oa);
            }
#pragma unroll
            for (int i = 0; i < 4; ++i)
#pragma unroll
                for (int s2 = 0; s2 < 2; ++s2) {
                    const bf16x8 sa = packs(S[i], s2);
                    const LAS unsigned char* qp = lds + OFF_QT + (c * 32 + r32) * HROWB + (32 * i + 16 * s2 + 4 * hi) * 2;
                    const bf16x8 bq = cat4(*(const LAS s16x4*)qp, *(const LAS s16x4*)(qp + 16));
                    if (i < 2) ob = MFMA32(sa, bq, ob); else oa = MFMA32(sa, bq, oa);
                }
#pragma unroll
            for (int i = 0; i < 4; ++i) {
#pragma unroll
                for (int g4 = 0; g4 < 4; ++g4) { const f32x4 dv = *(const LAS f32x4*)(DEC + c * 128 + 32 * i + 8 * g4 + 4 * hi);
#pragma unroll
                    for (int j = 0; j < 4; ++j) S[i][4 * g4 + j] *= dv[j]; }
#pragma unroll
                for (int k2 = 0; k2 < 2; ++k2) {
                    const bf16x8 a = *(const LAS bf16x8*)(lds + OFF_KET + (32 * i + r32) * HROWB + (c * 32 + 16 * k2 + 8 * hi) * 2);
                    const bf16x8 bv = *(const LAS bf16x8*)(lds + OFF_VT + (vb * 32 + r32) * HROWB + (c * 32 + 16 * k2 + 8 * hi) * 2);
                    S[i] = MFMA32(a, bv, S[i]);
                }
            }
            float ss = 0.f;
#pragma unroll
            for (int r = 0; r < 16; ++r) { o[c][r] = oa[r] + ob[r]; ss += o[c][r] * o[c][r]; }
            ss += __shfl_xor(ss, 32);
            if (hi == 0) SSb[(c * 4 + wid) * 32 + r32] = ss;
        }
    }
    u32x2 zgv[4][4];
    if (act) {
#pragma unroll
        for (int c = 0; c < 4; ++c)
#pragma unroll
            for (int g4 = 0; g4 < 4; ++g4) zgv[c][g4] = *(const u32x2*)(P.Z + (row0 + c * 32 + r32) * NIN + ZG + h * 128 + vb * 32 + 8 * g4 + 4 * hi);
    }
    __syncthreads();
    if (act) {
#pragma unroll
        for (int c = 0; c < 4; ++c) {
            const float tot = (SSb[(c * 4 + 0) * 32 + r32] + SSb[(c * 4 + 1) * 32 + r32]) + (SSb[(c * 4 + 2) * 32 + r32] + SSb[(c * 4 + 3) * 32 + r32]);
            const float rstd = rsqrtf(tot * (1.f / 128.f) + EPS);
            const size_t row = row0 + c * 32 + r32;
#pragma unroll
            for (int g4 = 0; g4 < 4; ++g4) {
                const int v0 = vb * 32 + 8 * g4 + 4 * hi;
                const u32x2 zg = zgv[c][g4];
                const f32x4 gn = *(const f32x4*)(P.hg_norm + v0);
                float gz[4] = {bflo(zg.x), bfhi(zg.x), bflo(zg.y), bfhi(zg.y)}; float ov[4];
#pragma unroll
                for (int j = 0; j < 4; ++j) ov[j] = o[c][4 * g4 + j] * rstd * gn[j] * (gz[j] * __builtin_amdgcn_rcpf(1.f + __expf(-gz[j])));
                u32x2 w; w.x = pk2(ov[0], ov[1]); w.y = pk2(ov[2], ov[3]);
                *(u32x2*)(P.MIX + row * DM + h * 128 + v0) = w;
            }
        }
    }
    __syncthreads();
}

template <class MaskF>
DI void swa_tile(const LAS unsigned char* KSb, int kstrideB, const LAS unsigned char* VTb, int vstrideB, const bf16x8 (&qf)[4], float sink, MaskF valid, bf16_t* orow, int r32, int hi) {
    f32x16 st[5];
#pragma unroll
    for (int kt = 0; kt < 5; ++kt) {
#pragma unroll
        for (int r = 0; r < 16; ++r) st[kt][r] = 0.f;
#pragma unroll
        for (int ks = 0; ks < 4; ++ks) { const bf16x8 a = *(const LAS bf16x8*)(KSb + (32 * kt + r32) * kstrideB + (16 * ks + 8 * hi) * 2); st[kt] = MFMA32(a, qf[ks], st[kt]); }
    }
    float m = sink;
#pragma unroll
    for (int kt = 0; kt < 5; ++kt)
#pragma unroll
        for (int r = 0; r < 16; ++r) { const int jr = 32 * kt + crow(r, hi); const float s = valid(jr) ? st[kt][r] * 0.125f : -INFINITY; st[kt][r] = s; m = fmaxf(m, s); }
    m = fmaxf(m, __shfl_xor(m, 32));
    float den = 0.f;
#pragma unroll
    for (int kt = 0; kt < 5; ++kt)
#pragma unroll
        for (int r = 0; r < 16; ++r) { const float p = __expf(st[kt][r] - m); st[kt][r] = p; den += p; }
    den += __shfl_xor(den, 32);
    den += __expf(sink - m);
    f32x16 o[2];
#pragma unroll
    for (int r = 0; r < 16; ++r) { o[0][r] = 0.f; o[1][r] = 0.f; }
#pragma unroll
    for (int kt = 0; kt < 5; ++kt)
#pragma unroll
        for (int s2 = 0; s2 < 2; ++s2) {
            const bf16x8 pb = packs(st[kt], s2);
#pragma unroll
            for (int dt = 0; dt < 2; ++dt) {
                const LAS unsigned char* vp = VTb + (32 * dt + r32) * vstrideB + (32 * kt + 16 * s2 + 4 * hi) * 2;
                const bf16x8 av = cat4(*(const LAS s16x4*)vp, *(const LAS s16x4*)(vp + 16));
                o[dt] = MFMA32(av, pb, o[dt]);
            }
        }
    const float inv = 1.f / den;
#pragma unroll
    for (int dt = 0; dt < 2; ++dt)
#pragma unroll
        for (int g4 = 0; g4 < 4; ++g4) { const int d0 = 32 * dt + 8 * g4 + 4 * hi;
            u32x2 w; w.x = pk2(o[dt][4 * g4] * inv, o[dt][4 * g4 + 1] * inv); w.y = pk2(o[dt][4 * g4 + 2] * inv, o[dt][4 * g4 + 3] * inv);
            *(u32x2*)(orow + d0) = w; }
}

constexpr int PK_STRB = 144, PV_STRB = 528, P_OFF_V = 256 * PK_STRB;
DI void swa_prompt_unit(LAS unsigned char* lds, const Ptrs& P, int unit) {
    const int tid = threadIdx.x, lane = tid & 63, wid = __builtin_amdgcn_readfirstlane(tid >> 6), r32 = lane & 31, hi = lane >> 5;
    const int kvh = unit & 1, n = (unit >> 1) & 31, b = unit >> 6;
    const long rowk0 = (long)b * SEQ + (long)(n - 1) * 128;
    const int g = wid >> 1, half = wid & 1, qh = kvh * 4 + g;
    bf16x8 qf[2][4];
#pragma unroll
    for (int sub = 0; sub < 2; ++sub)
#pragma unroll
        for (int ks = 0; ks < 4; ++ks) qf[sub][ks] = *(const bf16x8*)(P.Z + ((size_t)b * SEQ + n * 128 + 64 * half + 32 * sub + r32) * NIN + ZSQ + qh * 64 + 16 * ks + 8 * hi);
#pragma unroll
    for (int i = 0; i < 4; ++i) {
        const int q = tid + 512 * i, j = q >> 3, part = q & 7;
        u32x4 kv = (u32x4){0u, 0u, 0u, 0u}, vv = (u32x4){0u, 0u, 0u, 0u};
        if (n > 0 || j >= 128) { const bf16_t* zr = P.Z + (size_t)(rowk0 + j) * NIN + kvh * 64 + part * 8; kv = *(const u32x4*)(zr + ZSK); vv = *(const u32x4*)(zr + ZSV); }
        *(LAS u32x4*)(lds + j * PK_STRB + part * 16) = kv;
        LAS bf16_t* vt = (LAS bf16_t*)(lds + P_OFF_V + (part * 8) * PV_STRB + j * 2);
        const unsigned vw[4] = {vv.x, vv.y, vv.z, vv.w};
#pragma unroll
        for (int e = 0; e < 4; ++e) { vt[(2 * e) * (PV_STRB / 2)] = (bf16_t)(vw[e] & 0xffffu); vt[(2 * e + 1) * (PV_STRB / 2)] = (bf16_t)(vw[e] >> 16); }
    }
    __syncthreads();
    const float sink = P.sinks[qh];
    const int jmin = n == 0 ? 128 : 0;
#pragma unroll
    for (int sub = 0; sub < 2; ++sub) {
        const int i0 = 64 * half + 32 * sub;
        const size_t row = (size_t)b * SEQ + n * 128 + i0 + r32;
        auto valid = [=](int jr) { return (jr > r32) && (jr <= r32 + 128) && (i0 + jr >= jmin); };
        swa_tile(lds + i0 * PK_STRB, PK_STRB, lds + P_OFF_V + i0 * 2, PV_STRB, qf[sub], sink, valid, P.MIX + row * DM + 512 + qh * 64, r32, hi);
    }
    __syncthreads();
}

constexpr int SK_STRB = 144, SV_STRB = 336, S_OFF_V = 2 * 160 * SK_STRB;
static_assert(S_OFF_V + 2 * 64 * SV_STRB <= LDS_BYTES, "swa sample lds");
DI void swa_sample_unit(LAS unsigned char* lds, const Ptrs& P, int b) {
    const int tid = threadIdx.x, lane = tid & 63, wid = __builtin_amdgcn_readfirstlane(tid >> 6), r32 = lane & 31, hi = lane >> 5;
    float* okb = P.out + O_KS + (size_t)b * 16384; float* ovb = P.out + O_VS + (size_t)b * 16384;
#pragma unroll
    for (int i = 0; i < 8; ++i) {
        const int q = tid + 512 * i, j = q >> 5, c4 = q & 31, kvh = c4 >> 4, d0 = (c4 & 15) * 4;
        const f32x4 kf = *(const f32x4*)(P.ck + (size_t)b * 16384 + j * 128 + c4 * 4);
        const f32x4 vf = *(const f32x4*)(P.cv + (size_t)b * 16384 + j * 128 + c4 * 4);
        if (j >= 8) { *(f32x4*)(okb + (j - 8) * 128 + c4 * 4) = kf; *(f32x4*)(ovb + (j - 8) * 128 + c4 * 4) = vf; }
        u32x2 kw; kw.x = pk2(kf[0], kf[1]); kw.y = pk2(kf[2], kf[3]);
        *(LAS u32x2*)(lds + (kvh * 160 + j) * SK_STRB + d0 * 2) = kw;
        const unsigned v01 = pk2(vf[0], vf[1]), v23 = pk2(vf[2], vf[3]);
        LAS bf16_t* vt = (LAS bf16_t*)(lds + S_OFF_V + (kvh * 64 + d0) * SV_STRB + j * 2);
        vt[0] = (bf16_t)(v01 & 0xffffu); vt[SV_STRB / 2] = (bf16_t)(v01 >> 16); vt[2 * (SV_STRB / 2)] = (bf16_t)(v23 & 0xffffu); vt[3 * (SV_STRB / 2)] = (bf16_t)(v23 >> 16);
    }
    for (int e = tid; e < 2048; e += 512) {
        const int isv = e >> 10, s = (e >> 7) & 7, c = e & 127, kvh = c >> 6, d = c & 63;
        const bf16_t raw = P.Z[(size_t)(NTP + b * 8 + s) * NIN + (isv ? ZSV : ZSK) + c];
        (isv ? ovb : okb)[(120 + s) * 128 + c] = bf2f(raw);
        if (isv) *(LAS bf16_t*)(lds + S_OFF_V + (kvh * 64 + d) * SV_STRB + (128 + s) * 2) = raw;
        else *(LAS bf16_t*)(lds + (kvh * 160 + 128 + s) * SK_STRB + d * 2) = raw;
    }
    for (int e = tid; e < 2 * 24 * 64; e += 512) {
        const int kvh = e / 1536, rem = e % 1536, jj = rem >> 6, d = rem & 63;
        *(LAS bf16_t*)(lds + (kvh * 160 + 136 + jj) * SK_STRB + d * 2) = 0;
        *(LAS bf16_t*)(lds + S_OFF_V + (kvh * 64 + d) * SV_STRB + (136 + jj) * 2) = 0;
    }
    __syncthreads();
    if (wid < 2) {
        const int kvh = wid, g = r32 >> 3, s = r32 & 7, qh = kvh * 4 + g;
        const size_t row = (size_t)NTP + b * 8 + s;
        auto valid = [=](int jr) { return jr < 128 ? (jr > s) : (jr - 128 <= s); };
        bf16x8 qf[4];
#pragma unroll
        for (int ks = 0; ks < 4; ++ks) qf[ks] = *(const bf16x8*)(P.Z + row * NIN + ZSQ + qh * 64 + 16 * ks + 8 * hi);
        swa_tile(lds + kvh * 160 * SK_STRB, SK_STRB, lds + S_OFF_V + kvh * 64 * SV_STRB, SV_STRB, qf, P.sinks[qh], valid, P.MIX + row * DM + 512 + qh * 64, r32, hi);
    }
    __syncthreads();
}

DI void hgrn_sample_unit(LAS unsigned char* lds, const Ptrs& P, int unit) {
    const int tid = threadIdx.x, lane = tid & 63, wid = __builtin_amdgcn_readfirstlane(tid >> 6), hi = lane >> 5;
    const int b = unit >> 2, h = unit & 3;
    const int dg = tid >> 5, vq = tid & 31;
    const size_t soff = ((size_t)unit * 128 + dg * 8) * 128 + vq * 4;
    f32x4 S[8];
#pragma unroll
    for (int i = 0; i < 8; ++i) S[i] = *(const f32x4*)(P.state + soff + i * 128);
    LAS float* Fs = (LAS float*)lds; LAS float* Ks = Fs + 1024; LAS float* Qs = Ks + 1024; LAS float* Vs = Qs + 1024; LAS float* Gs = Vs + 1024; LAS float* OP = Gs + 1024;
    for (int e = tid; e < 1024; e += 512) {
        const int t = e >> 7, d = e & 127;
        const bf16_t* zr = P.Z + (size_t)(NTP + b * 8 + t) * NIN + h * 128 + d;
        const float zq = bf2f(zr[ZQ]), zi = bf2f(zr[ZI]), zg = bf2f(zr[ZG]); float zf = bf2f(zr[ZF]); zf = fminf(fmaxf(zf, -30.f), 30.f);
        const float l0 = P.lb_logits[h * 128 + d], l1 = P.lb_logits[512 + h * 128 + d];
        const float lbv = 1.f / (1.f + __expf(l1 - l0)), oml = 1.f - lbv;
        const float ex = __expf(-zf), sg = 1.f / (1.f + ex);
        Fs[e] = lbv + oml * sg; Ks[e] = oml * ex * sg; Qs[e] = zq / (1.f + __expf(-zq)); Vs[e] = zi; Gs[e] = zg / (1.f + __expf(-zg));
    }
    __syncthreads();
#pragma unroll 1
    for (int t = 0; t < 8; ++t) {
        const f32x4 v = *(const LAS f32x4*)(Vs + t * 128 + vq * 4); f32x4 op = (f32x4){0.f, 0.f, 0.f, 0.f};
#pragma unroll
        for (int i = 0; i < 8; ++i) { const int d = dg * 8 + i; const float f = Fs[t * 128 + d], k = Ks[t * 128 + d], q = Qs[t * 128 + d];
            S[i] = S[i] * f + v * k; op += S[i] * q; }
#pragma unroll
        for (int j = 0; j < 4; ++j) op[j] += __shfl_xor(op[j], 32);
        if (hi == 0) *(LAS f32x4*)(OP + (t * 8 + wid) * 128 + vq * 4) = op;
    }
    float* so = P.out + O_SS + soff;
#pragma unroll
    for (int i = 0; i < 8; ++i) *(f32x4*)(so + i * 128) = S[i];
    __syncthreads();
    {
        const int t = wid; float o0 = 0.f, o1 = 0.f;
#pragma unroll
        for (int w = 0; w < 8; ++w) { o0 += OP[(t * 8 + w) * 128 + lane]; o1 += OP[(t * 8 + w) * 128 + 64 + lane]; }
        const float rstd = rsqrtf(wave_sum(o0 * o0 + o1 * o1) * (1.f / 128.f) + EPS);
        bf16_t* mo = P.MIX + (size_t)(NTP + b * 8 + t) * DM + h * 128;
        mo[lane] = (bf16_t)(pk2(o0 * rstd * P.hg_norm[lane] * Gs[t * 128 + lane], 0.f) & 0xffffu);
        mo[64 + lane] = (bf16_t)(pk2(o1 * rstd * P.hg_norm[64 + lane] * Gs[t * 128 + 64 + lane], 0.f) & 0xffffu);
    }
    __syncthreads();
}

DI void scan_phase(const Ptrs& P, int G, int skip) {
    if ((int)blockIdx.x < skip) return;
    const int gt = ((int)blockIdx.x - skip) * 512 + threadIdx.x, NT = (G - skip) * 512;
    for (int idx = gt; idx < 32 * 2048; idx += NT) {
        const int bh = idx >> 11, q = idx & 2047, k = q & 1, ln = (q >> 1) & 63, i = (q >> 7) & 3, vb = q >> 9, hi_ = ln >> 5;
        const int d0 = 32 * i + 16 * k + 4 * hi_;
        bf16_t* hp = P.HS + (size_t)bh * 32 * 16384 + q * 8; const float* dp = P.DSC + bh * 32 * 128 + d0;
        float S[8];
#pragma unroll
        for (int j = 0; j < 8; ++j) S[j] = 0.f;
#pragma unroll 1
        for (int s0 = 0; s0 < 32; s0 += 8) {
            u32x4 Hv[8]; f32x4 da[8], db[8];
#pragma unroll
            for (int j = 0; j < 8; ++j) { Hv[j] = *(const u32x4*)(hp + (size_t)(s0 + j) * 16384); da[j] = *(const f32x4*)(dp + (s0 + j) * 128); db[j] = *(const f32x4*)(dp + (s0 + j) * 128 + 8); }
#pragma unroll
            for (int j = 0; j < 8; ++j) {
                u32x4 w; w.x = pk2(S[0], S[1]); w.y = pk2(S[2], S[3]); w.z = pk2(S[4], S[5]); w.w = pk2(S[6], S[7]);
                *(u32x4*)(hp + (size_t)(s0 + j) * 16384) = w;
                S[0] = S[0] * da[j][0] + bflo(Hv[j].x); S[1] = S[1] * da[j][1] + bfhi(Hv[j].x); S[2] = S[2] * da[j][2] + bflo(Hv[j].y); S[3] = S[3] * da[j][3] + bfhi(Hv[j].y);
                S[4] = S[4] * db[j][0] + bflo(Hv[j].z); S[5] = S[5] * db[j][1] + bfhi(Hv[j].z); S[6] = S[6] * db[j][2] + bflo(Hv[j].w); S[7] = S[7] * db[j][3] + bfhi(Hv[j].w);
            }
        }
        float* so = P.out + O_SP + (size_t)bh * 16384 + vb * 32 + (ln & 31);
#pragma unroll
        for (int j = 0; j < 4; ++j) { so[(d0 + j) * 128] = S[j]; so[(d0 + 8 + j) * 128] = S[4 + j]; }
    }
    for (int e = gt; e < 8 * 128 * 256; e += NT) {
        const int b = e >> 15, j = (e >> 8) & 127, c = e & 255;
        const float v = bf2f(P.Z[(size_t)(b * SEQ + SEQ - 128 + j) * NIN + ZSK + c]);
        if (c < 128) P.out[O_KP + (size_t)(b * 128 + j) * 128 + c] = v; else P.out[O_VP + (size_t)(b * 128 + j) * 128 + (c - 128)] = v;
    }
}

DI void final_norm(const Ptrs& P, int G) {
    const int tid = threadIdx.x, lane = tid & 63, wave = tid >> 6;
    const int gw = blockIdx.x * 8 + wave, NGW = G * 8;
    f32x4 ga[2], gb[2];
#pragma unroll
    for (int j = 0; j < 2; ++j) { ga[j] = *(const f32x4*)(P.ln_final + 8 * lane + 512 * j); gb[j] = *(const f32x4*)(P.ln_final + 8 * lane + 512 * j + 4); }
    for (int m0 = gw; m0 < NTP; m0 += 4 * NGW) {
        u32x4 w[4][2]; bool has[4]; int mm[4];
#pragma unroll
        for (int q = 0; q < 4; ++q) { const int m = m0 + q * NGW; has[q] = m < NTP; mm[q] = has[q] ? m : m0;
#pragma unroll
            for (int j = 0; j < 2; ++j) w[q][j] = *(const u32x4*)(P.XN + (size_t)mm[q] * DM + 8 * lane + 512 * j); }
#pragma unroll
        for (int q = 0; q < 4; ++q) {
            f32x4 va[2], vb[2]; float s = 0.f;
#pragma unroll
            for (int j = 0; j < 2; ++j) { va[j] = (f32x4){bflo(w[q][j].x), bfhi(w[q][j].x), bflo(w[q][j].y), bfhi(w[q][j].y)}; vb[j] = (f32x4){bflo(w[q][j].z), bfhi(w[q][j].z), bflo(w[q][j].w), bfhi(w[q][j].w)};
                s += (va[j].x * va[j].x + va[j].y * va[j].y) + (va[j].z * va[j].z + va[j].w * va[j].w) + (vb[j].x * vb[j].x + vb[j].y * vb[j].y) + (vb[j].z * vb[j].z + vb[j].w * vb[j].w); }
            const float r = rsqrtf(wave_sum(s) * (1.f / DM) + EPS);
            if (has[q]) { float* yo = P.out + (size_t)mm[q] * DM + 8 * lane;
#pragma unroll
                for (int j = 0; j < 2; ++j) { *(f32x4*)(yo + 512 * j) = va[j] * r * ga[j]; *(f32x4*)(yo + 512 * j + 4) = vb[j] * r * gb[j]; } }
        }
    }
    for (int m = NTP + gw; m < M; m += NGW) {
        f32x4 va[2], vb[2]; float s = 0.f;
#pragma unroll
        for (int j = 0; j < 2; ++j) { const u32x4 w = *(const u32x4*)(P.XN + (size_t)m * DM + 8 * lane + 512 * j);
            va[j] = (f32x4){bflo(w.x), bfhi(w.x), bflo(w.y), bfhi(w.y)}; vb[j] = (f32x4){bflo(w.z), bfhi(w.z), bflo(w.w), bfhi(w.w)}; }
#pragma unroll 4
        for (int sl = 0; sl < 16; ++sl) { const float* pr = P.PART + ((size_t)sl * NTS + (m - NTP)) * DM + 8 * lane;
#pragma unroll
            for (int j = 0; j < 2; ++j) { va[j] += *(const f32x4*)(pr + 512 * j); vb[j] += *(const f32x4*)(pr + 512 * j + 4); } }
#pragma unroll
        for (int j = 0; j < 2; ++j) s += (va[j].x * va[j].x + va[j].y * va[j].y) + (va[j].z * va[j].z + va[j].w * va[j].w) + (vb[j].x * vb[j].x + vb[j].y * vb[j].y) + (vb[j].z * vb[j].z + vb[j].w * vb[j].w);
        const float r = rsqrtf(wave_sum(s) * (1.f / DM) + EPS);
        float* yo = P.out + (size_t)m * DM + 8 * lane;
#pragma unroll
        for (int j = 0; j < 2; ++j) { *(f32x4*)(yo + 512 * j) = va[j] * r * ga[j]; *(f32x4*)(yo + 512 * j + 4) = vb[j] * r * gb[j]; }
    }
}

#define XB_TMO      128
#define XB_XCNT(j)  (256  + 64 * (j))
#define XB_XSUB(j)  (1280 + 64 * (j))
#define XB_XGEN(j)  (2304 + 64 * (j))
#define XB_TOP      3328
#define XB_TOPGEN   3392
#define XCD_BAR_WORDS 3456
#define XB_SPIN_CAP (1u << 18)
DI unsigned xb_ld(unsigned* p)              { return __hip_atomic_load(p, __ATOMIC_RELAXED, __HIP_MEMORY_SCOPE_AGENT); }
DI unsigned xb_add(unsigned* p, unsigned v) { return __hip_atomic_fetch_add(p, v, __ATOMIC_RELAXED, __HIP_MEMORY_SCOPE_AGENT); }
DI unsigned xb_xcc_id() { return (unsigned)__builtin_amdgcn_s_getreg((3 << 11) | 20) & 0xFu; }
#define XB_SPIN(cond, bar) do { unsigned _sp = 0; while (cond) { __builtin_amdgcn_s_sleep(1); \
    if ((++_sp & 255u) == 0u) { if (xb_ld(&(bar)[XB_TMO])) break; if (_sp > XB_SPIN_CAP) { atomicAdd(&(bar)[XB_TMO], 1u); break; } } } } while (0)
struct XcdBarrier { unsigned* bar; unsigned x; volatile LAS unsigned* st; };
DI XcdBarrier xcd_barrier_post(unsigned* bar, volatile LAS unsigned* st) {
    XcdBarrier b; b.bar = bar; b.x = xb_xcc_id(); b.st = st;
    if (threadIdx.x == 0) (void)xb_add(&bar[XB_XCNT(b.x)], 1u);
    return b;
}
DI void xcd_barrier_complete(unsigned* bar, unsigned x, unsigned& nloc, unsigned& nx) {
    const unsigned G = gridDim.x * gridDim.y * gridDim.z;
    unsigned sum, cnt, mine, sp = 0u;
    for (;;) {
        sum = 0u; cnt = 0u; mine = 0u;
#pragma unroll
        for (unsigned j = 0; j < 16; ++j) { const unsigned c = xb_ld(&bar[XB_XCNT(j)]); sum += c; cnt += (c > 0u) ? 1u : 0u; mine = (j == x) ? c : mine; }
        if (sum == G) break;
        __builtin_amdgcn_s_sleep(1);
        if ((++sp & 255u) == 0u) { if (xb_ld(&bar[XB_TMO])) break; if (sp > XB_SPIN_CAP) { atomicAdd(&bar[XB_TMO], 1u); break; } }
    }
    nloc = mine > 0u ? mine : 1u; nx = cnt > 0u ? cnt : 1u;
}
DI void xcd_barrier(const XcdBarrier& b) {
    asm volatile("s_waitcnt vmcnt(0)" ::: "memory");
    __syncthreads();
    if (threadIdx.x == 0) {
        unsigned* bar = b.bar;
        __builtin_amdgcn_s_waitcnt(0);
        unsigned nloc = b.st[0], nx = b.st[1];
        if (nloc == 0u) { xcd_barrier_complete(bar, b.x, nloc, nx); b.st[0] = nloc; b.st[1] = nx; }
        const unsigned old = xb_add(&bar[XB_XSUB(b.x)], 1u);
        const unsigned gen = old / nloc;
        if (old + 1u == (gen + 1u) * nloc) {
            __builtin_amdgcn_fence(__ATOMIC_RELEASE, "agent");
            asm volatile("s_waitcnt vmcnt(0)" ::: "memory");
            const unsigned og = xb_add(&bar[XB_TOP], 1u);
            const unsigned tg = og / nx;
            if (og + 1u == (tg + 1u) * nx) xb_add(&bar[XB_TOPGEN], 1u);
            else XB_SPIN(xb_ld(&bar[XB_TOPGEN]) == tg, bar);
            __builtin_amdgcn_fence(__ATOMIC_ACQUIRE, "agent");
            xb_add(&bar[XB_XGEN(b.x)], 1u);
            asm volatile("s_waitcnt vmcnt(0)" ::: "memory");
        } else {
            XB_SPIN(xb_ld(&bar[XB_XGEN(b.x)]) == gen, bar);
            __builtin_amdgcn_fence(__ATOMIC_ACQUIRE, "agent");
            asm volatile("s_waitcnt vmcnt(0)" ::: "memory");
        }
    }
    __syncthreads();
}

struct Args { const float* in[15]; float* out; unsigned char* ws; int ph_lo, ph_hi; };
constexpr int NPHASE = 9;

__global__ void __launch_bounds__(512, 2) mk_fwd(Args args) {
    extern __shared__ __attribute__((aligned(16))) unsigned char lds_raw[];
    LAS unsigned char* lds = (LAS unsigned char*)lds_raw;
    cg::grid_group grid = cg::this_grid();
    const int G = gridDim.x;
    Ptrs P;
    P.x_p = args.in[0]; P.x_s = args.in[1]; P.state = args.in[2]; P.ck = args.in[3]; P.cv = args.in[4]; P.ln_mix = args.in[5]; P.w_in = args.in[6]; P.lb_logits = args.in[7];
    P.hg_norm = args.in[8]; P.sinks = args.in[9]; P.w_out = args.in[10]; P.ln_mlp = args.in[11]; P.w_up = args.in[12]; P.w_down = args.in[13]; P.ln_final = args.in[14];
    P.out = args.out;
    unsigned char* ws = args.ws;
    P.WinT = (bf16_t*)(ws + WS_WIN); P.WoutT = (bf16_t*)(ws + WS_WOUT); P.WupT = (bf16_t*)(ws + WS_WUP); P.WdnT = (bf16_t*)(ws + WS_WDN);
    P.XN = (bf16_t*)(ws + WS_XN); P.Z = (bf16_t*)(ws + WS_Z); P.MIX = (bf16_t*)(ws + WS_MIX); P.U = (bf16_t*)(ws + WS_U);
    P.HS = (bf16_t*)(ws + WS_HS); P.DSC = (float*)(ws + WS_DSC); P.rss1 = (float*)(ws + WS_RSS1); P.rss2 = (float*)(ws + WS_RSS2); P.PART = (float*)(ws + WS_PART);
    const int lo = args.ph_lo, hi = args.ph_hi;
    unsigned* barw = (unsigned*)(ws + WS_BAR);
    volatile LAS unsigned* misc = (volatile LAS unsigned*)(lds + LDS_MISC);
    if (threadIdx.x < 2) misc[threadIdx.x] = 0u;
    __syncthreads();
    if (hi < 0) grid.sync();
    XcdBarrier xbar = xcd_barrier_post(barw, misc);
#define IN(k) (lo <= (k) && (k) < hi)
#define SEAM(k) do { if (IN(k) && IN((k) + 1)) xcd_barrier(xbar); } while (0)
    if (IN(0)) { p0_prologue(lds, P, G); if (PROBE_P0) { __syncthreads(); p0_prologue(lds, P, G); } }
    SEAM(0);
    if (PROBE_SYNC) { for (int i = 0; i < 8; ++i) grid.sync(); }
    if (IN(1)) { pg8::Gemm g{P.XN, P.WinT, DM, DM / 64}; pg8::StaticOrder S; S.init(M, NIN, G, (int)blockIdx.x); pg8::EpiZ E{P.Z, NIN, P.rss2};
        pg8::gemm_phase<pg8::EpiZ, pg8::StaticOrder, true>(lds, g, S, E); }
    SEAM(1);
    if (IN(2)) {
        for (int rep = 0; rep < 1 + PROBE_P2A; ++rep)
        for (int u = blockIdx.x; u < 1024; u += G) hgrn_unit<false>(lds, P, u);
        for (int rep = 0; rep < 1 + PROBE_P2A; ++rep) {
        for (int u = blockIdx.x; u < 512; u += G) swa_prompt_unit(lds, P, u);
        for (int u = blockIdx.x; u < 512; u += G) hgrn_sample_unit(lds, P, u);
        for (int u = blockIdx.x; u < 128; u += G) swa_sample_unit(lds, P, u); }
    }
    SEAM(2);
    if (IN(3)) {
        { pg8::Gemm g{P.MIX, P.WoutT, DM, DM / 64}; pg8::RectOrder S; S.init(NTP / 256, NTS / 256, DM / 256, 1, DM / 64, G, (int)blockIdx.x); pg8::EpiRes1 E{P.XN, P.rss1};
          pg8::gemm_phase<pg8::EpiRes1, pg8::RectOrder, true>(lds, g, S, E); }
        scan_phase(P, G, G > 32 ? 16 : 0);
    }
    SEAM(3);
    if (IN(4)) { for (int rep = 0; rep < 1 + PROBE_P2C; ++rep) for (int u = blockIdx.x; u < 1024; u += G) hgrn_unit<true>(lds, P, u); }
    SEAM(4);
    if (IN(5)) {
        { pg8::Gemm g{P.MIX, P.WoutT, DM, DM / 64}; pg8::StaticOrder S; S.init(NTP, DM, G, (int)blockIdx.x); pg8::EpiRes1 E{P.XN, P.rss1};
          pg8::gemm_phase<pg8::EpiRes1, pg8::StaticOrder, true>(lds, g, S, E); }
        { pg8::Gemm g{P.XN, P.WupT, DM, DM / 64}; pg8::RectOrder S; S.init(NTP / 256, NTS / 256, FF / 256, 1, DM / 64, G, (int)blockIdx.x); pg8::EpiUp E{P.U, FF, P.rss1};
          pg8::gemm_phase<pg8::EpiUp, pg8::RectOrder, true>(lds, g, S, E); }
        if (PROBE_P3) {
            { pg8::Gemm g{P.MIX, P.WoutT, DM, DM / 64}; pg8::StaticOrder S; S.init(NTP, DM, G, (int)blockIdx.x); pg8::EpiRes1 E{P.Z, P.rss1};
              pg8::gemm_phase<pg8::EpiRes1, pg8::StaticOrder, true>(lds, g, S, E); }
            { pg8::Gemm g{P.XN, P.WupT, DM, DM / 64}; pg8::RectOrder S; S.init(NTP / 256, NTS / 256, FF / 256, 1, DM / 64, G, (int)blockIdx.x); pg8::EpiUp E{P.U, FF, P.rss1};
              pg8::gemm_phase<pg8::EpiUp, pg8::RectOrder, true>(lds, g, S, E); }
        }
    }
    SEAM(5);
    if (IN(6)) {
        { pg8::Gemm g{P.XN, P.WupT, DM, DM / 64}; pg8::StaticOrder S; S.init(NTP, FF, G, (int)blockIdx.x); pg8::EpiUp E{P.U, FF, P.rss1};
          pg8::gemm_phase<pg8::EpiUp, pg8::StaticOrder, true>(lds, g, S, E); }
        { pg8::Gemm g{P.U, P.WdnT, FF, 4}; pg8::RectOrder S; S.init(NTP / 256, NTS / 256, DM / 256, 16, 4, G, (int)blockIdx.x); pg8::EpiDown<true> E{P.XN, P.PART};
          pg8::gemm_phase<pg8::EpiDown<true>, pg8::RectOrder, true, true>(lds, g, S, E); }
    }
    SEAM(6);
    if (IN(7)) { pg8::Gemm g{P.U, P.WdnT, FF, FF / 64}; pg8::StaticOrder S; S.init(NTP, DM, G, (int)blockIdx.x); pg8::EpiDown<false> E{P.XN, nullptr};
        pg8::gemm_phase<pg8::EpiDown<false>, pg8::StaticOrder, true>(lds, g, S, E); }
    SEAM(7);
    if (IN(8)) { final_norm(P, G); }
#undef IN
#undef SEAM
}

extern "C" void kernel_launch(void* const* d_in, const int* in_sizes, int n_in, void* d_out, int out_size, void* d_ws, size_t ws_size, hipStream_t stream) {
    static int grid = 0;
    if (grid == 0) {
        if (n_in != 15 || (size_t)out_size != O_END || ws_size < WS_END) { fprintf(stderr, "kernel_launch: unexpected shapes (n_in %d out %d ws %zu)\n", n_in, out_size, ws_size); grid = -1; return; }
        int dev = 0, cus = 0, per_cu = 0;
        (void)hipGetDevice(&dev); (void)hipDeviceGetAttribute(&cus, hipDeviceAttributeMultiprocessorCount, dev);
        if (hipFuncSetAttribute((const void*)mk_fwd, hipFuncAttributeMaxDynamicSharedMemorySize, LDS_BYTES) != hipSuccess) { fprintf(stderr, "kernel_launch: hipFuncSetAttribute failed\n"); grid = -1; return; }
        if (hipOccupancyMaxActiveBlocksPerMultiprocessor(&per_cu, (const void*)mk_fwd, 512, LDS_BYTES) != hipSuccess || per_cu < 1) { fprintf(stderr, "kernel_launch: occupancy query says %d\n", per_cu); per_cu = 1; }
        (void)hipGetLastError();
        if (per_cu > 1) per_cu = 1;
        grid = cus * per_cu;
    }
    if (grid < 0) return;
    if (hipMemsetAsync((char*)d_ws + WS_BAR, 0, 16384, stream) != hipSuccess) { fprintf(stderr, "kernel_launch: memset of the barrier words failed\n"); return; }
    Args a{};
    for (int i = 0; i < 15; ++i) a.in[i] = (const float*)d_in[i];
    a.out = (float*)d_out; a.ws = (unsigned char*)d_ws;
#if MK_COOP
    a.ph_lo = 0; a.ph_hi = NPHASE;
    void* kargs[] = {&a};
    hipError_t e = hipLaunchCooperativeKernel((const void*)mk_fwd, dim3(grid), dim3(512), kargs, LDS_BYTES, stream);
    if (e != hipSuccess) fprintf(stderr, "cooperative launch failed: %s (grid %d)\n", hipGetErrorString(e), grid);
#else
    for (int p = 0; p < NPHASE; ++p) { a.ph_lo = p; a.ph_hi = p + 1; hipLaunchKernelGGL(mk_fwd, dim3(grid), dim3(512), LDS_BYTES, stream, a); }
#endif
}
```
